# Optimizing an MI355X kernel written in HIP

```python
import math
import jax, jax.numpy as jnp
from jax import lax
import numpy as np

D_MODEL = 1024
BATCH = 32
SEQ = 2048
DEPTH = 4

GRID_W = 64
CTX_LEN = 256
N_MIXERS = 2
N_RET = (DEPTH + N_MIXERS - 1) // N_MIXERS
N_POOL = DEPTH // N_MIXERS
RET_HEADS = 4
RET_QK_DIM = D_MODEL // RET_HEADS
RET_V_DIM = 2 * D_MODEL // RET_HEADS
RET_QK_TOTAL = RET_HEADS * RET_QK_DIM
RET_V_TOTAL = RET_HEADS * RET_V_DIM
RET_CHUNK = 128
POOL_WINDOWS = (2, 4, 8, 16)
POOL_GROUP = D_MODEL // len(POOL_WINDOWS)
FFN_HIDDEN = ((8 * D_MODEL + 3 * 256 - 1) // (3 * 256)) * 256
ROPE_THETA = 10000.0
EPS = 1e-6
GN_EPS = 1e-5

kernel_name = "hybrid_retention_pool_dit_trunk"


def _rmsnorm(x, w):
    x32 = x.astype(jnp.float32)
    y = x32 * lax.rsqrt(jnp.mean(x32 * x32, axis=-1, keepdims=True) + EPS)
    return (y * w.astype(jnp.float32)).astype(x.dtype)


def _modulate(h, shift, scale):
    return h * (1.0 + scale) + shift


def _rope(x, pos):
    d = x.shape[-1]
    inv = ROPE_THETA ** (-jnp.arange(0, d, 2, dtype=jnp.float32) / d)
    ang = pos[:, None] * inv[None, :]
    cos = jnp.cos(ang)[None, :, None, :].astype(x.dtype)
    sin = jnp.sin(ang)[None, :, None, :].astype(x.dtype)
    x1, x2 = x[..., : d // 2], x[..., d // 2:]
    return jnp.concatenate([x1 * cos - x2 * sin, x1 * sin + x2 * cos], axis=-1)


def _axial_rope(x, row, col):
    half = x.shape[-1] // 2
    return jnp.concatenate([_rope(x[..., :half], row), _rope(x[..., half:], col)], axis=-1)


def _retention_direction(q, k, v, log_g, s0, strict):
    bsz, length, heads, _ = q.shape
    dv = v.shape[-1]
    n_chunks = length // RET_CHUNK

    def to_chunks(t):
        return t.astype(jnp.float32).reshape(bsz, n_chunks, RET_CHUNK, heads, t.shape[-1]).transpose(1, 0, 3, 2, 4)

    qc, kc, vc = to_chunks(q), to_chunks(k), to_chunks(v)
    idx = jnp.arange(RET_CHUNK, dtype=jnp.float32)
    diff = idx[:, None] - idx[None, :]
    mask = (diff > 0) if strict else (diff >= 0)
    intra = jnp.where(mask, jnp.exp(log_g[:, None, None] * jnp.where(mask, diff, 0.0)), 0.0)
    q_decay = jnp.exp(log_g[:, None] * (idx + 1.0))[..., None]
    k_decay = jnp.exp(log_g[:, None] * (RET_CHUNK - 1.0 - idx))[..., None]
    chunk_decay = jnp.exp(log_g * RET_CHUNK)[:, None, None]

    def step(state, xs):
        qb, kb, vb = xs
        scores = jnp.einsum('bhid,bhjd->bhij', qb, kb) * intra
        out = (jnp.einsum('bhij,bhje->bhie', scores, vb)
               + jnp.einsum('bhid,bhde->bhie', qb * q_decay, state))
        state = state * chunk_decay + jnp.einsum('bhjd,bhje->bhde', kb * k_decay, vb)
        return state, out

    s_fin, out = lax.scan(step, s0.astype(jnp.float32), (qc, kc, vc))
    out = out.transpose(1, 0, 3, 2, 4).reshape(bsz, length, heads, dv)
    return out, s_fin


def _retention_output(y, g, gn_w, w_out, dtype):
    mu = jnp.mean(y, axis=-1, keepdims=True)
    var = jnp.mean(jnp.square(y - mu), axis=-1, keepdims=True)
    yn = ((y - mu) * lax.rsqrt(var + GN_EPS)).reshape(y.shape[0], y.shape[1], -1) * gn_w.astype(jnp.float32)
    return (jax.nn.silu(g.astype(jnp.float32)) * yn).astype(dtype) @ w_out


def _split_proj(p):
    bsz, length, _ = p.shape
    q = p[..., :RET_QK_TOTAL].reshape(bsz, length, RET_HEADS, RET_QK_DIM)
    k = p[..., RET_QK_TOTAL:2 * RET_QK_TOTAL].reshape(bsz, length, RET_HEADS, RET_QK_DIM)
    v = p[..., 2 * RET_QK_TOTAL:2 * RET_QK_TOTAL + RET_V_TOTAL].reshape(bsz, length, RET_HEADS, RET_V_DIM)
    g = p[..., 2 * RET_QK_TOTAL + RET_V_TOTAL:]
    return q, k, v, g


def _retention_mixer(h_lat, h_ctx, w_in, log_decay, gn_w, w_out, row, col, ctx_out):
    bsz = h_lat.shape[0]
    n_ctx = h_ctx.shape[1]
    lg = -jnp.abs(log_decay.astype(jnp.float32))
    q_scale = RET_QK_DIM ** -0.5
    zeros = jnp.zeros((bsz, RET_HEADS, RET_QK_DIM, RET_V_DIM), jnp.float32)
    flip = lambda t: jnp.flip(t, axis=1)

    if ctx_out:
        qc, kc, vc, gc = _split_proj(h_ctx @ w_in)
        qc = qc * q_scale
        yc_f, s_f = _retention_direction(qc, kc, vc, lg[0], zeros, False)
        yc_b, s_b = _retention_direction(flip(qc), flip(kc), flip(vc), lg[1], zeros, True)
        y_ctx = _retention_output(yc_f + flip(yc_b), gc, gn_w, w_out, h_ctx.dtype)
    else:
        p_kv = h_ctx @ w_in[:, RET_QK_TOTAL:2 * RET_QK_TOTAL + RET_V_TOTAL]
        kc = p_kv[..., :RET_QK_TOTAL].reshape(bsz, n_ctx, RET_HEADS, RET_QK_DIM).astype(jnp.float32)
        vc = p_kv[..., RET_QK_TOTAL:].reshape(bsz, n_ctx, RET_HEADS, RET_V_DIM).astype(jnp.float32)
        m = jnp.arange(n_ctx, dtype=jnp.float32)
        w_f = jnp.exp((n_ctx - 1.0 - m)[:, None] * lg[0][None, :])[None, :, :, None]
        w_b = jnp.exp(m[:, None] * lg[1][None, :])[None, :, :, None]
        s_f = jnp.einsum('blhd,blhe->bhde', kc * w_f, vc)
        s_b = jnp.einsum('blhd,blhe->bhde', kc * w_b, vc)
        y_ctx = None

    q, k, v, g = _split_proj(h_lat @ w_in)
    q = _axial_rope(q, row, col) * q_scale
    k = _axial_rope(k, row, col)
    y_f, _ = _retention_direction(q, k, v, lg[0], s_f, False)
    y_b, _ = _retention_direction(flip(q), flip(k), flip(v), lg[1], s_b, True)
    y_lat = _retention_output(y_f + flip(y_b), g, gn_w, w_out, h_lat.dtype)
    return y_lat, y_ctx


def _pool_mixer(h, pool_w, pool_scale):
    length = h.shape[1]
    hf = h.astype(jnp.float32)
    cs = jnp.concatenate([jnp.zeros_like(hf[:, :1]), jnp.cumsum(hf, axis=1)], axis=1)
    t = jnp.arange(length)
    outs = []
    for gi, w in enumerate(POOL_WINDOWS):
        sl = slice(gi * POOL_GROUP, (gi + 1) * POOL_GROUP)
        lo = jnp.clip(t - w // 2, 0, length)
        hi = jnp.clip(t + w // 2, 0, length)
        csg = cs[:, :, sl]
        mean = (csg[:, hi] - csg[:, lo]) / (hi - lo).astype(jnp.float32)[None, :, None]
        outs.append(jnp.einsum('bld,de->ble', (mean - hf[:, :, sl]).astype(h.dtype), pool_w[gi]))
    return jnp.concatenate(outs, axis=-1) * pool_scale


def _swiglu(h, w_in, w_out):
    a, b = jnp.split(h @ w_in, 2, axis=-1)
    return (jax.nn.silu(a) * b) @ w_out


def setup_inputs(seed: int = 0) -> dict:
    key = jax.random.key(seed)
    ks = jax.random.split(key, 18)
    nrm = jax.random.normal
    f32 = jnp.float32
    base_decay = np.log(1.0 - 2.0 ** (-5.0 - np.arange(RET_HEADS))).astype(np.float32)
    return {
        "x": nrm(ks[0], (BATCH, SEQ, D_MODEL), f32),
        "c": nrm(ks[1], (BATCH, D_MODEL), f32),
        "ctx": nrm(ks[2], (BATCH, CTX_LEN, D_MODEL), f32),
        "c_ctx": nrm(ks[3], (D_MODEL,), f32),
        "ada_w": nrm(ks[4], (DEPTH, D_MODEL, 6 * D_MODEL), f32) * (0.5 * D_MODEL ** -0.5),
        "ada_b": 0.01 * nrm(ks[5], (DEPTH, 6 * D_MODEL), f32),
        "norm1_w": 1.0 + 0.05 * nrm(ks[6], (DEPTH, D_MODEL), f32),
        "norm2_w": 1.0 + 0.05 * nrm(ks[7], (DEPTH, D_MODEL), f32),
        "ret_w_in": nrm(ks[8], (N_RET, D_MODEL, 2 * RET_QK_TOTAL + 2 * RET_V_TOTAL), f32) * D_MODEL ** -0.5,
        "ret_log_decay": jnp.asarray(base_decay)[None, None, :] * (1.0 + 0.1 * nrm(ks[9], (N_RET, 2, RET_HEADS), f32)),
        "ret_gn_w": 1.0 + 0.05 * nrm(ks[10], (N_RET, RET_V_TOTAL), f32),
        "ret_w_out": nrm(ks[11], (N_RET, RET_V_TOTAL, D_MODEL), f32) * RET_V_TOTAL ** -0.5,
        "pool_w": nrm(ks[12], (N_POOL, len(POOL_WINDOWS), POOL_GROUP, POOL_GROUP), f32) * POOL_GROUP ** -0.5,
        "pool_scale": 1.0 + 0.05 * nrm(ks[13], (N_POOL, D_MODEL), f32),
        "ffn_w_in": nrm(ks[14], (DEPTH, D_MODEL, 2 * FFN_HIDDEN), f32) * D_MODEL ** -0.5,
        "ffn_w_out": nrm(ks[15], (DEPTH, FFN_HIDDEN, D_MODEL), f32) * FFN_HIDDEN ** -0.5,
        "final_norm_w": 1.0 + 0.05 * nrm(ks[16], (D_MODEL,), f32),
    }


def reference(x, c, ctx, c_ctx, ada_w, ada_b, norm1_w, norm2_w, ret_w_in, ret_log_decay, ret_gn_w,
              ret_w_out, pool_w, pool_scale, ffn_w_in, ffn_w_out, final_norm_w):
    n_lat = x.shape[1]
    ROWS = n_lat // GRID_W
    row = jnp.repeat(jnp.arange(ROWS), GRID_W).astype(jnp.float32)
    col = jnp.tile(jnp.arange(GRID_W), ROWS).astype(jnp.float32)
    silu_c = jax.nn.silu(c)
    silu_cc = jax.nn.silu(c_ctx)
    x_lat, x_ctx = x, ctx
    for i in range(DEPTH):
        last = i == DEPTH - 1
        use_ret = (i % N_MIXERS) == 0
        j = i // N_MIXERS
        ctx_needed = (not last) or use_ret
        sh1, sc1, g1, sh2, sc2, g2 = jnp.split((silu_c @ ada_w[i] + ada_b[i])[:, None, :], 6, axis=-1)
        h_lat = _modulate(_rmsnorm(x_lat, norm1_w[i]), sh1, sc1)
        if ctx_needed:
            csh1, csc1, cg1, csh2, csc2, cg2 = jnp.split(silu_cc @ ada_w[i] + ada_b[i], 6, axis=-1)
            h_ctx = _modulate(_rmsnorm(x_ctx, norm1_w[i]), csh1, csc1)
        if use_ret:
            y_lat, y_ctx = _retention_mixer(h_lat, h_ctx, ret_w_in[j], ret_log_decay[j], ret_gn_w[j],
                                            ret_w_out[j], row, col, not last)
        else:
            y_lat = _pool_mixer(h_lat, pool_w[j], pool_scale[j])
            y_ctx = None if last else _pool_mixer(h_ctx, pool_w[j], pool_scale[j])
        x_lat = x_lat + g1 * y_lat
        x_lat = x_lat + g2 * _swiglu(_modulate(_rmsnorm(x_lat, norm2_w[i]), sh2, sc2), ffn_w_in[i], ffn_w_out[i])
        if not last:
            x_ctx = x_ctx + cg1 * y_ctx
            x_ctx = x_ctx + cg2 * _swiglu(_modulate(_rmsnorm(x_ctx, norm2_w[i]), csh2, csc2),
                                          ffn_w_in[i], ffn_w_out[i])
    return _rmsnorm(x_lat, final_norm_w)
```

```cpp
#include <hip/hip_runtime.h>
#include <hip/hip_cooperative_groups.h>
#include <cstdio>
namespace cg = cooperative_groups;

#define LAS __attribute__((address_space(3)))
typedef unsigned short bf16_t;
typedef short bf16x8 __attribute__((ext_vector_type(8)));
typedef float f32x4 __attribute__((ext_vector_type(4)));
typedef float f32x2 __attribute__((ext_vector_type(2)));
typedef unsigned u32x4 __attribute__((ext_vector_type(4)));
typedef unsigned u32x2 __attribute__((ext_vector_type(2)));

constexpr int DM = 1024, NB = 32, SEQ = 2048, CTXL = 256, HID = 2816;
constexpr int TCTX = NB * CTXL;
constexpr int TT = TCTX + NB * SEQ;
constexpr int TH = TT / 2;
constexpr int LDS_BYTES = 135168;

constexpr size_t WS_X = 0;
constexpr size_t WS_R1 = 301989888ull;
constexpr size_t WS_Y = WS_R1 + 377487360ull;
constexpr size_t WS_BAR = WS_Y + 301989888ull;
constexpr size_t WS_ST = WS_BAR + 256;
constexpr size_t WS_END = WS_ST + 2359296ull;
constexpr size_t OB_H = 0;
constexpr size_t OB_W = 150994944ull;
constexpr size_t OB_MOD = 254803968ull;
constexpr size_t OB_CS = 258048000ull;
constexpr size_t W_RETIN = 0, W_RETOUT = 12582912ull, W_POOL = 16777216ull, W_FFNIN = 17301504ull, W_FFNOUT = 40370176ull;

struct Params {
    const float *x, *c, *ctx, *c_ctx, *ada_w, *ada_b, *norm1_w, *norm2_w, *ret_w_in, *ret_log_decay, *ret_gn_w, *ret_w_out, *pool_w, *pool_scale, *ffn_w_in, *ffn_w_out, *final_norm_w;
    float* out; unsigned char* ws;
};

__device__ __forceinline__ unsigned cvt_pk_bf16(float lo, float hi) { unsigned r; asm("v_cvt_pk_bf16_f32 %0, %1, %2" : "=v"(r) : "v"(lo), "v"(hi)); return r; }
__device__ __forceinline__ float bf_lo(unsigned u) { return __uint_as_float(u << 16); }
__device__ __forceinline__ float bf_hi(unsigned u) { return __uint_as_float(u & 0xffff0000u); }
__device__ __forceinline__ int opaque_tid() { int t = threadIdx.x; asm volatile("" : "+v"(t)); return t; }
__device__ __forceinline__ float silu_f(float v) { return v * __builtin_amdgcn_rcpf(1.0f + __expf(-v)); }
__device__ __forceinline__ f32x4 silu4(f32x4 v) {
    f32x4 e, r;
#pragma unroll
    for (int j = 0; j < 4; ++j) e[j] = __builtin_amdgcn_exp2f(v[j] * -1.4426950408889634f);
#pragma unroll
    for (int j = 0; j < 4; ++j) r[j] = __builtin_amdgcn_rcpf(1.0f + e[j]);
    return v * r;
}

namespace pg8 {
constexpr int BM = 256, BK = 64, HALF = 128, HTB = HALF * BK * 2, STAGE_BYTES = 8 * HTB, NXCD = 8, WGM = 4;
__host__ __device__ __forceinline__ int lds_byte(int r, int c) { const int st = (r >> 4) * 2 + (c >> 5), rr = r & 15, cc = c & 31, ob = rr * 64 + cc * 2; return st * 1024 + (ob ^ (((ob >> 9) & 1) << 5)); }
__host__ __device__ __forceinline__ void stage_rc(int b, int& R, int& C) { const int st = b / 1024, sb = b % 1024, swz = sb ^ (((sb >> 9) & 1) << 5); R = (st >> 1) * 16 + swz / 64; C = (st & 1) * 32 + (swz % 64) / 2; }
__host__ __device__ __forceinline__ int perm32(int rho) { const int n = rho >> 4, i = rho & 15; return 8 * (i >> 2) + 4 * n + (i & 3); }

struct Unit { int pm, pn; };
struct TileMap { int nctx, ctx0, lat0; __device__ __forceinline__ int src(int t) const { return t < nctx ? ctx0 + t : lat0 + (t - nctx); } };
struct Gemm { const bf16_t* A; const bf16_t* Bt; int lda, ldb, M, N, K; TileMap mapA, mapB; int a_pn_step; };

struct StaticOrder {
    int nM, nN, nwg, G, c;
    __device__ void init(int M, int N, int G_, int c_) { nM = M / BM; nN = N / BM; nwg = nM * nN; G = G_; c = c_; }
    __device__ bool next(int i, Unit& u) const {
        const long L = (long)i * G + c; if (L >= nwg) return false;
        int wgid = (int)L; { const int q = nwg / NXCD, r = nwg % NXCD, xcd = wgid % NXCD, off = wgid / NXCD; wgid = (xcd < r ? xcd * (q + 1) : r * (q + 1) + (xcd - r) * q) + off; }
        const int nig = WGM * nN, gid = wgid / nig, fm = gid * WGM, gsz = (nM - fm) < WGM ? (nM - fm) : WGM;
        u.pm = fm + ((wgid % nig) % gsz); u.pn = (wgid % nig) / gsz; return true;
    }
};

template <class Epi>
__device__ __forceinline__ void gemm_phase(LAS unsigned char* lds, const Gemm g, const Epi& E) {
    const int tid = opaque_tid(), wid = __builtin_amdgcn_readfirstlane(tid >> 6), lane = tid & 63, wr = wid >> 2, wc = wid & 3, fr = lane & 15, fq = lane >> 4;
    const int K = g.K, nt = K / BK;
    StaticOrder S; S.init(g.M, g.N, (int)gridDim.x, (int)blockIdx.x);
    unsigned voffA[2], voffB[2];
#pragma unroll
    for (int i = 0; i < 2; ++i) { int R, C; stage_rc(tid * 16 + i * 8192, R, C); const int Rb = Epi::PERM ? ((R & ~31) + perm32(R & 31)) : R;
        voffA[i] = (unsigned)(R * g.lda + C) * 2u; voffB[i] = (unsigned)(Rb * g.ldb + C) * 2u; }
    const size_t kstep = (size_t)(BK * 2);
    const size_t hstepA = (size_t)HALF * g.lda * 2, hstepB = (size_t)HALF * g.ldb * 2;
    const size_t tstepA = 2 * hstepA, tstepB = 2 * hstepB;
    const unsigned ldsw = (unsigned)wid * 1024u;
    const int aoff = lds_byte(wr * 64 + fr, fq * 8), boff = lds_byte(wc * 32 + fr, fq * 8);
#define PG8_SA(b, h) (((b) * 2 + (h)) * HTB)
#define PG8_SB(b, h) ((4 + (b) * 2 + (h)) * HTB)
#define PG8_STAGE(bufoff, gbase, voff) do { _Pragma("unroll") for (int _i = 0; _i < 2; ++_i) \
        __builtin_amdgcn_global_load_lds((const unsigned*)((const char*)(gbase) + (voff)[_i]), (LAS unsigned*)(lds + (bufoff) + ldsw + _i * 8192), 16, 0, 0); } while (0)
#define PG8_LDA(dst, b, h) do { _Pragma("unroll") for (int m = 0; m < 4; ++m) _Pragma("unroll") for (int k = 0; k < 2; ++k) dst[m][k] = *(const LAS bf16x8*)(lds + PG8_SA(b, h) + aoff + m * 2048 + k * 1024); } while (0)
#define PG8_LDB(dst, b, h) do { _Pragma("unroll") for (int n = 0; n < 2; ++n) _Pragma("unroll") for (int k = 0; k < 2; ++k) dst[n][k] = *(const LAS bf16x8*)(lds + PG8_SB(b, h) + boff + n * 2048 + k * 1024); } while (0)
#define PG8_MMA(ai, bj, At, Bt) do { __builtin_amdgcn_s_setprio(1); _Pragma("unroll") for (int m = 0; m < 4; ++m) _Pragma("unroll") for (int n = 0; n < 2; ++n) _Pragma("unroll") for (int k = 0; k < 2; ++k) \
        acc[ai][bj][m][n] = __builtin_amdgcn_mfma_f32_16x16x32_bf16(Bt[n][k], At[m][k], acc[ai][bj][m][n], 0, 0, 0); __builtin_amdgcn_s_setprio(0); } while (0)
#define PG8_WAIT_V(n) asm volatile("s_waitcnt vmcnt(" #n ")" ::: "memory")
#define PG8_WAIT_L(n) asm volatile("s_waitcnt lgkmcnt(" #n ")" ::: "memory")
#define PG8_BAR __builtin_amdgcn_s_barrier()
#define PG8_SCHED __builtin_amdgcn_sched_barrier(0)
    Unit cur, nxt; int ui = 0;
    if (!S.next(0, cur)) return;
    f32x4 acc[2][2][4][2];
#pragma unroll
    for (int a = 0; a < 2; ++a)
#pragma unroll
        for (int b = 0; b < 2; ++b)
#pragma unroll
            for (int m = 0; m < 4; ++m)
#pragma unroll
                for (int n = 0; n < 2; ++n) acc[a][b][m][n] = (f32x4){0.f, 0.f, 0.f, 0.f};
    bf16x8 At[4][2], B0[2][2], B1[2][2];
    const char* cA = (const char*)g.A + (size_t)g.mapA.src(cur.pm) * tstepA + (size_t)cur.pn * g.a_pn_step;
    const char* cB = (const char*)g.Bt + (size_t)g.mapB.src(cur.pn) * tstepB;
    PG8_STAGE(PG8_SB(0, 0), cB, voffB); PG8_STAGE(PG8_SA(0, 0), cA, voffA); PG8_STAGE(PG8_SB(0, 1), cB + hstepB, voffB); PG8_STAGE(PG8_SA(0, 1), cA + hstepA, voffA);
    if (wr == 1) PG8_BAR;
    PG8_WAIT_V(4); PG8_BAR;
    PG8_STAGE(PG8_SB(1, 0), cB + kstep, voffB); PG8_STAGE(PG8_SA(1, 0), cA + kstep, voffA); PG8_STAGE(PG8_SB(1, 1), cB + hstepB + kstep, voffB);
    PG8_WAIT_V(6); PG8_BAR;
    for (;;) {
        const bool has_next = S.next(ui + 1, nxt);
        const char* nA = has_next ? (const char*)g.A + (size_t)g.mapA.src(nxt.pm) * tstepA + (size_t)nxt.pn * g.a_pn_step : cA;
        const char* nB = has_next ? (const char*)g.Bt + (size_t)g.mapB.src(nxt.pn) * tstepB : cB;
        for (int t = 0; t < nt; t += 2) {
            const bool last = (t == nt - 2);
            const char* a1 = cA + (size_t)(t + 1) * kstep;
            const char* a2 = last ? nA : cA + (size_t)(t + 2) * kstep; const char* b2 = last ? nB : cB + (size_t)(t + 2) * kstep;
            const char* a3 = a2 + kstep; const char* b3 = b2 + kstep;
            PG8_LDB(B0, 0, 0); PG8_SCHED; PG8_LDA(At, 0, 0); PG8_STAGE(PG8_SA(1, 1), a1 + hstepA, voffA);
            PG8_WAIT_L(8); PG8_BAR; PG8_WAIT_L(0); PG8_MMA(0, 0, At, B0); PG8_BAR; PG8_SCHED;
            PG8_LDB(B1, 0, 1); PG8_STAGE(PG8_SB(0, 0), b2, voffB);
            PG8_BAR; PG8_WAIT_L(0); PG8_MMA(0, 1, At, B1); PG8_BAR;
            PG8_LDA(At, 0, 1); PG8_STAGE(PG8_SA(0, 0), a2, voffA);
            PG8_BAR; PG8_WAIT_L(0); PG8_MMA(1, 0, At, B0); PG8_BAR; PG8_SCHED;
            PG8_STAGE(PG8_SB(0, 1), b2 + hstepB, voffB);
            PG8_WAIT_V(6); PG8_BAR; PG8_MMA(1, 1, At, B1); PG8_BAR;
            PG8_LDB(B0, 1, 0); PG8_SCHED; PG8_LDA(At, 1, 0); PG8_STAGE(PG8_SA(0, 1), a2 + hstepA, voffA);
            PG8_WAIT_L(8); PG8_BAR; PG8_WAIT_L(0); PG8_MMA(0, 0, At, B0); PG8_BAR; PG8_SCHED;
            PG8_LDB(B1, 1, 1); PG8_STAGE(PG8_SB(1, 0), b3, voffB);
            PG8_BAR; PG8_WAIT_L(0); PG8_MMA(0, 1, At, B1); PG8_BAR;
            PG8_LDA(At, 1, 1); PG8_STAGE(PG8_SA(1, 0), a3, voffA);
            PG8_BAR; PG8_WAIT_L(0); PG8_MMA(1, 0, At, B0); PG8_BAR; PG8_SCHED;
            PG8_STAGE(PG8_SB(1, 1), b3 + hstepB, voffB);
            PG8_WAIT_V(6); PG8_BAR; PG8_MMA(1, 1, At, B1); PG8_BAR;
        }
        E(acc, cur, wr, wc, fr, fq);
        if (!has_next) break;
#pragma unroll
        for (int a = 0; a < 2; ++a)
#pragma unroll
            for (int b = 0; b < 2; ++b)
#pragma unroll
                for (int m = 0; m < 4; ++m)
#pragma unroll
                    for (int n = 0; n < 2; ++n) acc[a][b][m][n] = (f32x4){0.f, 0.f, 0.f, 0.f};
        cur = nxt; cA = nA; cB = nB; ++ui;
    }
    PG8_WAIT_V(0);
    if (wr == 0) PG8_BAR;
    PG8_BAR;
#undef PG8_SA
#undef PG8_SB
#undef PG8_STAGE
#undef PG8_LDA
#undef PG8_LDB
#undef PG8_MMA
#undef PG8_WAIT_V
#undef PG8_WAIT_L
#undef PG8_BAR
#undef PG8_SCHED
}
}
using pg8::Unit; using pg8::TileMap; using pg8::Gemm;

typedef f32x4 AccT[2][2][4][2];

struct EpiRes {
    static constexpr bool PERM = false;
    float* X; const float* Xc; const float* Xl; const float* modl; int gi; const float* scale; TileMap mapA;
    __device__ __forceinline__ void operator()(const AccT& acc, const Unit& u, int wr, int wc, int fr, int fq) const {
        asm volatile("" : "+v"(fr), "+v"(fq));
        const int gpm = mapA.src(u.pm);
        const int mb = gpm < 32 ? 32 : (gpm - 32) >> 3;
        const int row0 = gpm * 256 + wr * 64 + fr, col0 = u.pn * 256 + wc * 32 + 4 * fq;
        const float* gp = modl + ((size_t)mb * 6 + gi) * 1024;
        f32x4 gv[2][2];
#pragma unroll
        for (int bj = 0; bj < 2; ++bj)
#pragma unroll
            for (int n = 0; n < 2; ++n) { gv[bj][n] = *(const f32x4*)(gp + col0 + bj * 128 + n * 16); if (scale) gv[bj][n] = gv[bj][n] * *(const f32x4*)(scale + col0 + bj * 128 + n * 16); }
        const float* sbase = (gpm < 32 ? Xc : Xl) + (size_t)row0 * 1024 + col0;
#pragma unroll
        for (int ai = 0; ai < 2; ++ai) {
            f32x4 xo[4][2][2];
#pragma unroll
            for (int m = 0; m < 4; ++m)
#pragma unroll
                for (int bj = 0; bj < 2; ++bj)
#pragma unroll
                    for (int n = 0; n < 2; ++n) xo[m][bj][n] = *(const f32x4*)(sbase + (size_t)(ai * 128 + m * 16) * 1024 + bj * 128 + n * 16);
            __builtin_amdgcn_sched_barrier(0);
#pragma unroll
            for (int m = 0; m < 4; ++m) { float* rowp = X + (size_t)(row0 + ai * 128 + m * 16) * 1024 + col0;
#pragma unroll
                for (int bj = 0; bj < 2; ++bj)
#pragma unroll
                    for (int n = 0; n < 2; ++n) *(f32x4*)(rowp + bj * 128 + n * 16) = xo[m][bj][n] + gv[bj][n] * acc[ai][bj][m][n]; }
            __builtin_amdgcn_sched_barrier(0);
        }
    }
};

struct EpiQK {
    static constexpr bool PERM = true;
    bf16_t* Q; bf16_t* Kk; bf16_t* Vv; const f32x2* cs; TileMap mapA;
    __device__ __forceinline__ void operator()(const AccT& acc, const Unit& u, int wr, int wc, int fr, int fq) const {
        asm volatile("" : "+v"(fr), "+v"(fq));
        const int gpm = mapA.src(u.pm);
        const bool isq = u.pn < 4, isv = u.pn >= 8;
        const bool lat = gpm >= 32 && !isv;
        bf16_t* base = isq ? Q : (isv ? Vv + (size_t)(u.pn - 8) * 256 : Kk);
        const int hh = isv ? 0 : (u.pn & 3);
        const int ldo = isv ? 2048 : 1024;
        const float osc = isq ? 0.0625f : 1.0f;
        const int p0 = 16 * wc + 4 * fq;
        f32x4 ctR[2][2], ctC[4][2];
        if (lat) {
#pragma unroll
            for (int ai = 0; ai < 2; ++ai) { const int pr = ((gpm - 32) * 4 + 2 * ai + wr) & 31;
                ctR[ai][0] = *(const f32x4*)(cs + pr * 64 + p0); ctR[ai][1] = *(const f32x4*)(cs + pr * 64 + p0 + 2); }
#pragma unroll
            for (int m = 0; m < 4; ++m) { const int pc = m * 16 + fr;
                ctC[m][0] = *(const f32x4*)(cs + pc * 64 + p0); ctC[m][1] = *(const f32x4*)(cs + pc * 64 + p0 + 2); }
        }
        __builtin_amdgcn_sched_barrier(0);
#pragma unroll
        for (int ai = 0; ai < 2; ++ai)
#pragma unroll
            for (int m = 0; m < 4; ++m) {
                const int rl = ai * 128 + wr * 64 + m * 16 + fr;
                bf16_t* rowp = base + (size_t)(u.pm * 256 + rl) * ldo + hh * 256 + wc * 32 + 8 * fq;
#pragma unroll
                for (int bj = 0; bj < 2; ++bj) {
                    f32x4 v0 = acc[ai][bj][m][0], v1 = acc[ai][bj][m][1];
                    if (lat) {
                        const f32x4 c01 = bj ? ctC[m][0] : ctR[ai][0], c23 = bj ? ctC[m][1] : ctR[ai][1];
                        f32x4 r0, r1;
                        r0[0] = v0[0] * c01[0] - v0[1] * c01[1]; r0[1] = v0[0] * c01[1] + v0[1] * c01[0];
                        r0[2] = v0[2] * c01[2] - v0[3] * c01[3]; r0[3] = v0[2] * c01[3] + v0[3] * c01[2];
                        r1[0] = v1[0] * c23[0] - v1[1] * c23[1]; r1[1] = v1[0] * c23[1] + v1[1] * c23[0];
                        r1[2] = v1[2] * c23[2] - v1[3] * c23[3]; r1[3] = v1[2] * c23[3] + v1[3] * c23[2];
                        v0 = r0; v1 = r1;
                    }
                    v0 = v0 * osc; v1 = v1 * osc;
                    u32x4 w; w.x = cvt_pk_bf16(v0[0], v0[1]); w.y = cvt_pk_bf16(v0[2], v0[3]); w.z = cvt_pk_bf16(v1[0], v1[1]); w.w = cvt_pk_bf16(v1[2], v1[3]);
                    *(u32x4*)(rowp + bj * 128) = w;
                }
            }
    }
};

struct EpiSiluGN {
    static constexpr bool PERM = true;
    bf16_t* A2; TileMap mapA; const bf16_t* Y; const f32x2* ST; const float* gnw;
    __device__ __forceinline__ void operator()(const AccT& acc, const Unit& u, int wr, int wc, int fr, int fq) const {
        asm volatile("" : "+v"(fr), "+v"(fq));
        const int row0 = mapA.src(u.pm) * 256 + wr * 64 + fr, col0 = u.pn * 256 + wc * 32 + 8 * fq;
        const int hd = u.pn >> 1;
        f32x4 gw[2][2]; f32x2 st[2][4];
#pragma unroll
        for (int bj = 0; bj < 2; ++bj) { gw[bj][0] = *(const f32x4*)(gnw + col0 + bj * 128); gw[bj][1] = *(const f32x4*)(gnw + col0 + bj * 128 + 4); }
#pragma unroll
        for (int ai = 0; ai < 2; ++ai)
#pragma unroll
            for (int m = 0; m < 4; ++m) st[ai][m] = ST[(size_t)(row0 + ai * 128 + m * 16) * 4 + hd];
#pragma unroll
        for (int ai = 0; ai < 2; ++ai) {
            u32x4 yv[4][2];
#pragma unroll
            for (int m = 0; m < 4; ++m)
#pragma unroll
                for (int bj = 0; bj < 2; ++bj) yv[m][bj] = *(const u32x4*)(Y + (size_t)(row0 + ai * 128 + m * 16) * 2048 + col0 + bj * 128);
            __builtin_amdgcn_sched_barrier(0);
#pragma unroll
            for (int m = 0; m < 4; ++m) { bf16_t* rowp = A2 + (size_t)(row0 + ai * 128 + m * 16) * 2048 + col0;
                const float mu = st[ai][m][0], rs = st[ai][m][1];
#pragma unroll
                for (int bj = 0; bj < 2; ++bj) { const f32x4 v0 = acc[ai][bj][m][0], v1 = acc[ai][bj][m][1]; const u32x4 yw = yv[m][bj];
                    const f32x4 y0 = (f32x4){bf_lo(yw.x), bf_hi(yw.x), bf_lo(yw.y), bf_hi(yw.y)}, y1 = (f32x4){bf_lo(yw.z), bf_hi(yw.z), bf_lo(yw.w), bf_hi(yw.w)};
                    const f32x4 n0 = (y0 - mu) * rs * gw[bj][0], n1 = (y1 - mu) * rs * gw[bj][1];
                    const f32x4 s0 = silu4(v0) * n0, s1 = silu4(v1) * n1;
                    u32x4 w; w.x = cvt_pk_bf16(s0[0], s0[1]); w.y = cvt_pk_bf16(s0[2], s0[3]); w.z = cvt_pk_bf16(s1[0], s1[1]); w.w = cvt_pk_bf16(s1[2], s1[3]);
                    *(u32x4*)(rowp + bj * 128) = w; } }
            __builtin_amdgcn_sched_barrier(0);
        }
    }
};

struct EpiSwiglu {
    static constexpr bool PERM = true;
    bf16_t* U; TileMap mapA;
    __device__ __forceinline__ void operator()(const AccT& acc, const Unit& u, int wr, int wc, int fr, int fq) const {
        asm volatile("" : "+v"(fr), "+v"(fq));
        const int gpm = mapA.src(u.pm);
        const int row0 = gpm * 256 + wr * 64 + fr, col0 = u.pn * 128 + wc * 32 + 8 * fq;
#pragma unroll
        for (int ai = 0; ai < 2; ++ai)
#pragma unroll
            for (int m = 0; m < 4; ++m) { bf16_t* rowp = U + (size_t)(row0 + ai * 128 + m * 16) * HID + col0;
                const f32x4 s0 = silu4(acc[ai][0][m][0]) * acc[ai][1][m][0], s1 = silu4(acc[ai][0][m][1]) * acc[ai][1][m][1];
                u32x4 w; w.x = cvt_pk_bf16(s0[0], s0[1]); w.y = cvt_pk_bf16(s0[2], s0[3]); w.z = cvt_pk_bf16(s1[0], s1[1]); w.w = cvt_pk_bf16(s1[2], s1[3]);
                *(u32x4*)rowp = w; }
    }
};

__device__ void norm_phase(const float* Xc, const float* Xl, bf16_t* H, const float* nw, const float* modl, int shi, int sci, int r0, int r1) {
    const int tid_ = opaque_tid(); const int wid = tid_ >> 6, lane = tid_ & 63;
    for (int row = r0 + (blockIdx.x * 8 + wid) * 4; row < r1; row += gridDim.x * 32) {
        const float* xp = (row < TCTX ? Xc : Xl) + (size_t)row * 1024 + lane * 4;
        f32x4 v[4][4]; float ss[4];
#pragma unroll
        for (int u = 0; u < 4; ++u)
#pragma unroll
            for (int q = 0; q < 4; ++q) v[u][q] = *(const f32x4*)(xp + u * 1024 + q * 256);
#pragma unroll
        for (int u = 0; u < 4; ++u) { float a = 0.f;
#pragma unroll
            for (int q = 0; q < 4; ++q) a += v[u][q][0] * v[u][q][0] + v[u][q][1] * v[u][q][1] + v[u][q][2] * v[u][q][2] + v[u][q][3] * v[u][q][3];
            ss[u] = a; }
#pragma unroll
        for (int o = 32; o >= 1; o >>= 1)
#pragma unroll
            for (int u = 0; u < 4; ++u) ss[u] += __int_as_float(__builtin_amdgcn_ds_bpermute((lane ^ o) << 2, __float_as_int(ss[u])));
        const int mb = row < TCTX ? 32 : (row - TCTX) >> 11;
        const float* shp = modl + ((size_t)mb * 6 + shi) * 1024; const float* scp = modl + ((size_t)mb * 6 + sci) * 1024;
#pragma unroll
        for (int q = 0; q < 4; ++q) { const int c = q * 256 + lane * 4;
            const f32x4 w = *(const f32x4*)(nw + c), sh = *(const f32x4*)(shp + c), sc = *(const f32x4*)(scp + c);
            const f32x4 wm = w * (sc + 1.0f);
#pragma unroll
            for (int u = 0; u < 4; ++u) { const float rstd = rsqrtf(ss[u] * (1.0f / 1024.0f) + 1e-6f);
                const f32x4 h = (v[u][q] * rstd) * wm + sh;
                u32x2 o; o.x = cvt_pk_bf16(h[0], h[1]); o.y = cvt_pk_bf16(h[2], h[3]);
                *(u32x2*)(H + (size_t)(row + u) * 1024 + c) = o; } }
    }
}

__device__ void final_norm_phase(const float* X, float* out, const float* nw) {
    const int tid_ = opaque_tid(); const int wid = tid_ >> 6, lane = tid_ & 63;
    for (int row = TCTX + (blockIdx.x * 8 + wid) * 4; row < TT; row += gridDim.x * 32) {
        const float* xp = X + (size_t)row * 1024 + lane * 4;
        f32x4 v[4][4]; float ss[4];
#pragma unroll
        for (int u = 0; u < 4; ++u)
#pragma unroll
            for (int q = 0; q < 4; ++q) v[u][q] = *(const f32x4*)(xp + u * 1024 + q * 256);
#pragma unroll
        for (int u = 0; u < 4; ++u) { float a = 0.f;
#pragma unroll
            for (int q = 0; q < 4; ++q) a += v[u][q][0] * v[u][q][0] + v[u][q][1] * v[u][q][1] + v[u][q][2] * v[u][q][2] + v[u][q][3] * v[u][q][3];
            ss[u] = a; }
#pragma unroll
        for (int o = 32; o >= 1; o >>= 1)
#pragma unroll
            for (int u = 0; u < 4; ++u) ss[u] += __int_as_float(__builtin_amdgcn_ds_bpermute((lane ^ o) << 2, __float_as_int(ss[u])));
#pragma unroll
        for (int q = 0; q < 4; ++q) { const int c = q * 256 + lane * 4; const f32x4 w = *(const f32x4*)(nw + c);
#pragma unroll
            for (int u = 0; u < 4; ++u) { const float rstd = rsqrtf(ss[u] * (1.0f / 1024.0f) + 1e-6f);
                *(f32x4*)(out + (size_t)(row + u - TCTX) * 1024 + c) = (v[u][q] * rstd) * w; } }
    }
}

template <int HW>
__device__ __forceinline__ void pool_item(const bf16_t* H, bf16_t* Dd, int row, int c) {
    int sb, L, t;
    if (row < TCTX) { sb = row & ~255; L = 256; t = row & 255; } else { sb = TCTX + ((row - TCTX) & ~2047); L = 2048; t = (row - TCTX) & 2047; }
    u32x4 wv[2 * HW];
#pragma unroll
    for (int k = 0; k < 2 * HW; ++k) { const int uu = t - HW + k; const bool ok = uu >= 0 && uu < L;
        wv[k] = ok ? *(const u32x4*)(H + (size_t)(sb + uu) * 1024 + c) : (u32x4){0u, 0u, 0u, 0u}; }
    float s[8];
#pragma unroll
    for (int j = 0; j < 8; ++j) s[j] = 0.f;
#pragma unroll
    for (int k = 0; k < 2 * HW; ++k) { const u32x4 w = wv[k];
        s[0] += bf_lo(w.x); s[1] += bf_hi(w.x); s[2] += bf_lo(w.y); s[3] += bf_hi(w.y); s[4] += bf_lo(w.z); s[5] += bf_hi(w.z); s[6] += bf_lo(w.w); s[7] += bf_hi(w.w); }
    const int lo = max(t - HW, 0), hi = min(t + HW, L);
    const float inv = 1.0f / (float)(hi - lo);
    const u32x4 w = wv[HW];
    u32x4 o;
    o.x = cvt_pk_bf16(s[0] * inv - bf_lo(w.x), s[1] * inv - bf_hi(w.x)); o.y = cvt_pk_bf16(s[2] * inv - bf_lo(w.y), s[3] * inv - bf_hi(w.y));
    o.z = cvt_pk_bf16(s[4] * inv - bf_lo(w.z), s[5] * inv - bf_hi(w.z)); o.w = cvt_pk_bf16(s[6] * inv - bf_lo(w.w), s[7] * inv - bf_hi(w.w));
    *(u32x4*)(Dd + (size_t)row * 1024 + c) = o;
}
__device__ void pool_phase(const bf16_t* H, bf16_t* Dd, int r0, int r1) {
    const int tid_ = opaque_tid(); const int wid = tid_ >> 6, lane = tid_ & 63;
    const int nw = (r1 - r0) * 2;
    for (int it = blockIdx.x * 8 + wid; it < nw; it += gridDim.x * 8) {
        const int gi = it & 3, row = r0 + (it >> 2) * 2 + (lane >> 5), c = gi * 256 + (lane & 31) * 8;
        if (gi == 0) pool_item<1>(H, Dd, row, c); else if (gi == 1) pool_item<2>(H, Dd, row, c); else if (gi == 2) pool_item<4>(H, Dd, row, c); else pool_item<8>(H, Dd, row, c);
    }
}

__device__ void stats_phase(const bf16_t* Y, f32x2* ST, int r0) {
    const int tid_ = opaque_tid(); const int wid = tid_ >> 6, lane = tid_ & 63;
    for (int row = r0 + blockIdx.x * 8 + wid; row < TT; row += gridDim.x * 8) {
        const size_t off = (size_t)row * 2048 + lane * 8;
        u32x4 yw[4];
#pragma unroll
        for (int hh = 0; hh < 4; ++hh) yw[hh] = *(const u32x4*)(Y + off + hh * 512);
        float y[4][8], sm[4], vq[4];
#pragma unroll
        for (int hh = 0; hh < 4; ++hh) { y[hh][0] = bf_lo(yw[hh].x); y[hh][1] = bf_hi(yw[hh].x); y[hh][2] = bf_lo(yw[hh].y); y[hh][3] = bf_hi(yw[hh].y); y[hh][4] = bf_lo(yw[hh].z); y[hh][5] = bf_hi(yw[hh].z); y[hh][6] = bf_lo(yw[hh].w); y[hh][7] = bf_hi(yw[hh].w);
            float a = 0.f;
#pragma unroll
            for (int j = 0; j < 8; ++j) a += y[hh][j];
            sm[hh] = a; }
#pragma unroll
        for (int o = 32; o >= 1; o >>= 1)
#pragma unroll
            for (int hh = 0; hh < 4; ++hh) sm[hh] += __int_as_float(__builtin_amdgcn_ds_bpermute((lane ^ o) << 2, __float_as_int(sm[hh])));
#pragma unroll
        for (int hh = 0; hh < 4; ++hh) { const float mu = sm[hh] * (1.0f / 512.0f); float a = 0.f; sm[hh] = mu;
#pragma unroll
            for (int j = 0; j < 8; ++j) { const float d = y[hh][j] - mu; a += d * d; }
            vq[hh] = a; }
#pragma unroll
        for (int o = 32; o >= 1; o >>= 1)
#pragma unroll
            for (int hh = 0; hh < 4; ++hh) vq[hh] += __int_as_float(__builtin_amdgcn_ds_bpermute((lane ^ o) << 2, __float_as_int(vq[hh])));
        if (lane < 4) { const float mu = lane == 0 ? sm[0] : (lane == 1 ? sm[1] : (lane == 2 ? sm[2] : sm[3])); const float v = lane == 0 ? vq[0] : (lane == 1 ? vq[1] : (lane == 2 ? vq[2] : vq[3]));
            ST[(size_t)row * 4 + lane] = (f32x2){mu, rsqrtf(v * (1.0f / 512.0f) + 1e-5f)}; }
    }
}

__device__ __forceinline__ int perm_qk(int c) { const int hh = c >> 8, hf = (c >> 7) & 1, dd = c & 127; return hh * 256 + hf * 128 + (dd & 1) * 64 + (dd >> 1); }

__device__ void conv_tile(const float* src, int srcN, bf16_t* dst, int K, int n0, int k0, int maptype, float* lds) {
    const int tid = opaque_tid();
    {
        const int kk = tid >> 6, nn = tid & 63, np = n0 + nn;
        int sc;
        if (maptype == 0) sc = np;
        else if (maptype == 1) sc = np < 2048 ? 4096 + np : (np < 3072 ? perm_qk(np - 2048) : (np < 4096 ? 1024 + perm_qk(np - 3072) : 2048 + (np - 4096)));
        else sc = ((np >> 7) & 1) * HID + (np >> 8) * 128 + (np & 127);
        float v[16];
#pragma unroll
        for (int ps = 0; ps < 16; ++ps) v[ps] = src[(size_t)(k0 + kk + 8 * ps) * srcN + sc];
#pragma unroll
        for (int ps = 0; ps < 16; ++ps) lds[(kk + 8 * ps) * 65 + nn] = v[ps];
    }
    __syncthreads();
    {
        const int nn = tid >> 3, kc = tid & 7;
#pragma unroll
        for (int hh = 0; hh < 2; ++hh) {
            float v[8];
#pragma unroll
            for (int e = 0; e < 8; ++e) v[e] = lds[(64 * hh + 8 * kc + e) * 65 + nn];
            u32x4 w; w.x = cvt_pk_bf16(v[0], v[1]); w.y = cvt_pk_bf16(v[2], v[3]); w.z = cvt_pk_bf16(v[4], v[5]); w.w = cvt_pk_bf16(v[6], v[7]);
            *(u32x4*)(dst + (size_t)(n0 + nn) * K + k0 + 64 * hh + 8 * kc) = w;
        }
    }
    __syncthreads();
}

__device__ void phase0(const Params& p, float* lds) {
    const int tid = opaque_tid(), wid = tid >> 6, lane = tid & 63;
    float* X = (float*)(p.ws + WS_X);
    bf16_t* Wb = (bf16_t*)((unsigned char*)p.out + OB_W);
    float* MOD = (float*)((unsigned char*)p.out + OB_MOD);
    f32x2* CS = (f32x2*)((unsigned char*)p.out + OB_CS);
    for (int idx = blockIdx.x * 512 + tid; idx < 4096; idx += gridDim.x * 512) {
        const int pos = idx >> 6, pp = idx & 63;
        const float inv = powf(10000.0f, -(float)(2 * pp) / 128.0f);
        const float angf = (float)pos * inv;
        double a = (double)angf;
        const double k = rint(a * 0.6366197723675814);
        const double rr = (a - k * 1.5707963267948966) - k * 6.123233995736766e-17;
        const int qd = ((int)k) & 3;
        const double r2 = rr * rr;
        double sn = rr * (1.0 + r2 * (-1.0 / 6 + r2 * (1.0 / 120 + r2 * (-1.0 / 5040 + r2 * (1.0 / 362880 + r2 * (-1.0 / 39916800 + r2 * (1.0 / 6227020800.0)))))));
        double cn = 1.0 + r2 * (-0.5 + r2 * (1.0 / 24 + r2 * (-1.0 / 720 + r2 * (1.0 / 40320 + r2 * (-1.0 / 3628800 + r2 * (1.0 / 479001600.0 + r2 * (-1.0 / 87178291200.0)))))));
        double cs_, sn_;
        if (qd == 0) { cs_ = cn; sn_ = sn; } else if (qd == 1) { cs_ = -sn; sn_ = cn; } else if (qd == 2) { cs_ = -cn; sn_ = -sn; } else { cs_ = sn; sn_ = -cn; }
        CS[idx] = (f32x2){(float)cs_, (float)sn_};
    }
    for (int it = blockIdx.x; it < 4 * 96; it += gridDim.x) {
        const int layer = it / 96, cb = it % 96;
        for (int idx = tid; idx < 33 * 1024; idx += 512) { const int r = idx >> 10, k = idx & 1023; const float v = r < 32 ? p.c[r * 1024 + k] : p.c_ctx[k]; lds[idx] = silu_f(v); }
        __syncthreads();
        const float* wp = p.ada_w + (size_t)layer * 1024 * 6144 + cb * 64 + lane;
        float acc[33];
#pragma unroll
        for (int r = 0; r < 33; ++r) acc[r] = 0.f;
        for (int k = wid * 128; k < wid * 128 + 128; k += 4) {
            const float w0 = wp[(size_t)k * 6144], w1 = wp[(size_t)(k + 1) * 6144], w2 = wp[(size_t)(k + 2) * 6144], w3 = wp[(size_t)(k + 3) * 6144];
#pragma unroll
            for (int r = 0; r < 33; ++r) { const f32x4 s4 = *(const f32x4*)(lds + r * 1024 + k); acc[r] += s4[0] * w0 + s4[1] * w1 + s4[2] * w2 + s4[3] * w3; }
        }
        __syncthreads();
#pragma unroll
        for (int r = 0; r < 33; ++r) lds[(wid * 33 + r) * 64 + lane] = acc[r];
        __syncthreads();
        for (int idx = tid; idx < 33 * 64; idx += 512) { const int r = idx >> 6, l = idx & 63; float sm = 0.f;
#pragma unroll
            for (int w = 0; w < 8; ++w) sm += lds[(w * 33 + r) * 64 + l];
            MOD[((size_t)layer * 33 + r) * 6144 + cb * 64 + l] = sm + p.ada_b[layer * 6144 + cb * 64 + l]; }
        __syncthreads();
    }
    for (int it = blockIdx.x; it < 6336; it += gridDim.x) {
        int i = it;
        if (i < 1536) { const int j = i / 768, r = i % 768, nt = r / 8, kt = r % 8;
            conv_tile(p.ret_w_in + (size_t)j * 1024 * 6144, 6144, Wb + W_RETIN + (size_t)j * 6144 * 1024, 1024, nt * 64, kt * 128, 1, lds); continue; }
        i -= 1536;
        if (i < 512) { const int j = i / 256, r = i % 256, nt = r / 16, kt = r % 16;
            conv_tile(p.ret_w_out + (size_t)j * 2048 * 1024, 1024, Wb + W_RETOUT + (size_t)j * 1024 * 2048, 2048, nt * 64, kt * 128, 0, lds); continue; }
        i -= 512;
        if (i < 64) { const int jg = i / 8, r = i % 8, nt = r / 2, kt = r % 2;
            conv_tile(p.pool_w + (size_t)jg * 65536, 256, Wb + W_POOL + (size_t)jg * 65536, 256, nt * 64, kt * 128, 0, lds); continue; }
        i -= 64;
        if (i < 2816) { const int l = i / 704, r = i % 704, nt = r / 8, kt = r % 8;
            conv_tile(p.ffn_w_in + (size_t)l * 1024 * 5632, 5632, Wb + W_FFNIN + (size_t)l * 5632 * 1024, 1024, nt * 64, kt * 128, 2, lds); continue; }
        i -= 2816;
        { const int l = i / 352, r = i % 352, nt = r / 22, kt = r % 22;
            conv_tile(p.ffn_w_out + (size_t)l * HID * 1024, 1024, Wb + W_FFNOUT + (size_t)l * 1024 * HID, HID, nt * 64, kt * 128, 0, lds); }
    }
}

constexpr int QS_LD = 264, KS_LD = 272, P_LD = 80;
template <int ST>
__device__ __forceinline__ void kt_issue(unsigned addr, u32x2 (&o)[8]) {
    constexpr int RB = KS_LD * 2;
    asm volatile(
        "ds_read_b64_tr_b16 %0, %8 offset:%9\n\t"
        "ds_read_b64_tr_b16 %1, %8 offset:%10\n\t"
        "ds_read_b64_tr_b16 %2, %8 offset:%11\n\t"
        "ds_read_b64_tr_b16 %3, %8 offset:%12\n\t"
        "ds_read_b64_tr_b16 %4, %8 offset:%13\n\t"
        "ds_read_b64_tr_b16 %5, %8 offset:%14\n\t"
        "ds_read_b64_tr_b16 %6, %8 offset:%15\n\t"
        "ds_read_b64_tr_b16 %7, %8 offset:%16"
        : "=&v"(o[0]), "=&v"(o[1]), "=&v"(o[2]), "=&v"(o[3]), "=&v"(o[4]), "=&v"(o[5]), "=&v"(o[6]), "=&v"(o[7])
        : "v"(addr),
          "n"((0 * 32 + 0) * RB + 32 * (2 * ST)), "n"((0 * 32 + 4) * RB + 32 * (2 * ST)),
          "n"((1 * 32 + 0) * RB + 32 * (2 * ST)), "n"((1 * 32 + 4) * RB + 32 * (2 * ST)),
          "n"((0 * 32 + 0) * RB + 32 * (2 * ST + 1)), "n"((0 * 32 + 4) * RB + 32 * (2 * ST + 1)),
          "n"((1 * 32 + 0) * RB + 32 * (2 * ST + 1)), "n"((1 * 32 + 4) * RB + 32 * (2 * ST + 1))
        : "memory");
}
template <int N>
__device__ __forceinline__ void kt_wait(u32x2 (&o)[8]) {
    asm volatile("s_waitcnt lgkmcnt(%8)" : "+v"(o[0]), "+v"(o[1]), "+v"(o[2]), "+v"(o[3]), "+v"(o[4]), "+v"(o[5]), "+v"(o[6]), "+v"(o[7]) : "n"(N) : "memory");
}
constexpr int VS_LD = 136;
__device__ __forceinline__ void vt_issue(unsigned addr, u32x2 (&o)[4]) {
    constexpr int RB = VS_LD * 2;
    asm volatile(
        "ds_read_b64_tr_b16 %0, %4 offset:%5\n\t"
        "ds_read_b64_tr_b16 %1, %4 offset:%6\n\t"
        "ds_read_b64_tr_b16 %2, %4 offset:%7\n\t"
        "ds_read_b64_tr_b16 %3, %4 offset:%8"
        : "=&v"(o[0]), "=&v"(o[1]), "=&v"(o[2]), "=&v"(o[3])
        : "v"(addr), "n"(0 * RB), "n"(4 * RB), "n"(32 * RB), "n"(36 * RB)
        : "memory");
}
__device__ __forceinline__ void vt_wait(u32x2 (&o)[4]) {
    asm volatile("s_waitcnt lgkmcnt(0)" : "+v"(o[0]), "+v"(o[1]), "+v"(o[2]), "+v"(o[3]) : : "memory");
}
__device__ __forceinline__ bf16x8 kt_frag(const u32x2& a, const u32x2& b) { return __builtin_bit_cast(bf16x8, (u32x4){a.x, a.y, b.x, b.y}); }
template <int ST, bool LAST>
__device__ __forceinline__ void kt_step(unsigned addr, u32x2 (&cur)[8], u32x2 (&nxt)[8], f32x4 (&S)[16], const bf16x8 (&Vs)[2], float Gc) {
    if constexpr (!LAST) kt_issue<ST + 1>(addr, nxt);
    kt_wait<LAST ? 0 : 8>(cur);
    constexpr int m0 = 2 * ST, m1 = 2 * ST + 1;
    S[m0] = S[m0] * Gc; S[m1] = S[m1] * Gc;
    S[m0] = __builtin_amdgcn_mfma_f32_16x16x32_bf16(kt_frag(cur[0], cur[1]), Vs[0], S[m0], 0, 0, 0);
    S[m1] = __builtin_amdgcn_mfma_f32_16x16x32_bf16(kt_frag(cur[4], cur[5]), Vs[0], S[m1], 0, 0, 0);
    S[m0] = __builtin_amdgcn_mfma_f32_16x16x32_bf16(kt_frag(cur[2], cur[3]), Vs[1], S[m0], 0, 0, 0);
    S[m1] = __builtin_amdgcn_mfma_f32_16x16x32_bf16(kt_frag(cur[6], cur[7]), Vs[1], S[m1], 0, 0, 0);
}
template <bool WITH_B>
__device__ __forceinline__ void scan_bc(const bf16_t* Ps, const bf16_t* Qs, int r, int g, const bf16x8 (&Vf)[2], const f32x4 (&S)[16], f32x4 (&o1)[4], f32x4 (&o2)[4]) {
    constexpr int S0 = WITH_B ? 0 : 2;
    u32x4 fb[2][4];
    const bf16_t* pp = Ps + r * P_LD + 8 * g;
    const bf16_t* qp = Qs + r * QS_LD + 4 * g;
    if constexpr (WITH_B) {
#pragma unroll
        for (int nt = 0; nt < 4; ++nt) fb[0][nt] = *(const u32x4*)(pp + 16 * nt * P_LD);
    } else {
#pragma unroll
        for (int nt = 0; nt < 4; ++nt) { const bf16_t* q2 = qp + 16 * nt * QS_LD; const u32x2 b0 = *(const u32x2*)q2, b1 = *(const u32x2*)(q2 + 16); fb[0][nt] = (u32x4){b0.x, b0.y, b1.x, b1.y}; }
    }
#pragma unroll
    for (int st = S0; st < 10; ++st) {
        const int nx = st + 1;
        if (nx < 2) {
#pragma unroll
            for (int nt = 0; nt < 4; ++nt) fb[nx & 1][nt] = *(const u32x4*)(pp + 16 * nt * P_LD + 32 * nx);
        } else if (nx < 10) {
#pragma unroll
            for (int nt = 0; nt < 4; ++nt) { const bf16_t* q2 = qp + 16 * nt * QS_LD + 32 * (nx - 2);
                const u32x2 b0 = *(const u32x2*)q2, b1 = *(const u32x2*)(q2 + 16); fb[nx & 1][nt] = (u32x4){b0.x, b0.y, b1.x, b1.y}; }
        }
        if (st < 2) {
#pragma unroll
            for (int nt = 0; nt < 4; ++nt) o1[nt] = __builtin_amdgcn_mfma_f32_16x16x32_bf16(Vf[st], __builtin_bit_cast(bf16x8, fb[st & 1][nt]), o1[nt], 0, 0, 0);
        } else {
            const int T = st - 2;
            u32x4 aw; aw.x = cvt_pk_bf16(S[2 * T][0], S[2 * T][1]); aw.y = cvt_pk_bf16(S[2 * T][2], S[2 * T][3]); aw.z = cvt_pk_bf16(S[2 * T + 1][0], S[2 * T + 1][1]); aw.w = cvt_pk_bf16(S[2 * T + 1][2], S[2 * T + 1][3]);
            const bf16x8 a = __builtin_bit_cast(bf16x8, aw);
#pragma unroll
            for (int nt = 0; nt < 4; ++nt) o2[nt] = __builtin_amdgcn_mfma_f32_16x16x32_bf16(a, __builtin_bit_cast(bf16x8, fb[st & 1][nt]), o2[nt], 0, 0, 0);
        }
        __builtin_amdgcn_sched_barrier(0);
    }
}

__device__ void ret_phase(const Params& p, unsigned char* ldsb, int lj, int half) {
    const int tid0 = opaque_tid(), w = __builtin_amdgcn_readfirstlane(tid0 >> 6), lane0 = tid0 & 63, r0_ = lane0 & 15, g0_ = lane0 >> 4;
    bf16_t* Qs = (bf16_t*)ldsb;
    bf16_t* Ks = Qs + 64 * QS_LD;
    bf16_t* Ps = Ks + 64 * KS_LD;
    bf16_t* Vl = Ps + 64 * P_LD;
    const bf16_t* Qg = (const bf16_t*)(p.ws + WS_R1);
    const bf16_t* Kg = Qg + (size_t)TH * 1024;
    const bf16_t* Vg = Kg + (size_t)TH * 1024;
    bf16_t* Y = (bf16_t*)(p.ws + WS_Y);
    const int jb = w & 3, ih = w >> 2;
    for (int item = blockIdx.x; item < 256; item += gridDim.x) {
        const int xq = item & 7, yq = item >> 3, sl = yq & 3, bh = (yq >> 2) * 8 + xq, bl = bh >> 2, h = bh & 3;
        const int bglob = half * 16 + bl;
        const float l2gF = -fabsf(p.ret_log_decay[(lj * 2 + 0) * 4 + h]) * 1.4426950408889634f, l2gB = -fabsf(p.ret_log_decay[(lj * 2 + 1) * 4 + h]) * 1.4426950408889634f;
        for (int pass = 0; pass < 2; ++pass) {
            const int dir = 1 - pass;
            const float lg = -fabsf(p.ret_log_decay[(lj * 2 + dir) * 4 + h]);
            const float l2g = lg * 1.4426950408889634f;
            const float Gc = __builtin_amdgcn_exp2f(64.0f * l2g);
            float ge[8];
#pragma unroll
            for (int e = 0; e < 8; ++e) ge[e] = __builtin_amdgcn_exp2f((dir == 0 ? -(float)e : (float)e) * l2g);
            f32x4 S[16];
#pragma unroll
            for (int i = 0; i < 16; ++i) S[i] = (f32x4){0.f, 0.f, 0.f, 0.f};
            u32x4 sq[4], sk[4]; u32x4 sv[2]; u32x2 yold[4];
            auto spos = [&](int c) -> int { return dir == 0 ? 64 * c : (c < 4 ? 192 - 64 * c : 2496 - 64 * c); };
            auto lrow = [&](int s0) -> int { return s0 < 256 ? bl * 256 + s0 : 4096 + bl * 2048 + (s0 - 256); };
            auto grow = [&](int s0) -> int { return s0 < 256 ? bglob * 256 + s0 : TCTX + bglob * 2048 + (s0 - 256); };
            const unsigned vo_qk = (unsigned)(((tid0 >> 5) * 1024 + (tid0 & 31) * 8) * 2);
            const unsigned vo_v = (unsigned)(((tid0 >> 4) * 2048 + (tid0 & 15) * 8) * 2);
            const unsigned vo_y = (unsigned)((r0_ * 2048 + 4 * g0_) * 2);
            auto issueQ = [&](int c) { const char* bq = (const char*)(Qg + (size_t)lrow(spos(c)) * 1024 + h * 256);
#pragma unroll
                for (int k = 0; k < 4; ++k) sq[k] = *(const u32x4*)(bq + (size_t)k * 32768 + vo_qk); };
            auto issueK = [&](int c) { const char* bk = (const char*)(Kg + (size_t)lrow(spos(c)) * 1024 + h * 256);
#pragma unroll
                for (int k = 0; k < 4; ++k) sk[k] = *(const u32x4*)(bk + (size_t)k * 32768 + vo_qk); };
            auto issueVY = [&](int c) { const char* bv = (const char*)(Vg + (size_t)lrow(spos(c)) * 2048 + h * 512 + sl * 128);
#pragma unroll
                for (int k = 0; k < 2; ++k) sv[k] = *(const u32x4*)(bv + (size_t)k * 131072 + vo_v);
                if (pass == 1) { const char* by = (const char*)(Y + (size_t)grow(spos(c)) * 2048 + h * 512 + sl * 128 + 16 * w);
#pragma unroll
                    for (int nt = 0; nt < 4; ++nt) yold[nt] = *(const u32x2*)(by + (size_t)nt * 65536 + vo_y); } };
            issueQ(0); issueK(0); issueVY(0);
            for (int c = 0; c < 36; ++c) {
                const int s0 = spos(c);
                int tid = tid0, r = r0_, g = g0_; asm volatile("" : "+v"(tid), "+v"(r), "+v"(g));
                const int grow0 = grow(s0);
#pragma unroll
                for (int k = 0; k < 4; ++k) { const int ch = tid + 512 * k, ri = ch >> 5, cc = ch & 31;
                    *(u32x4*)(Qs + ri * QS_LD + cc * 8) = sq[k]; *(u32x4*)(Ks + ri * KS_LD + cc * 8) = sk[k]; }
#pragma unroll
                for (int k = 0; k < 2; ++k) { const int ch = tid + 512 * k, ri = ch >> 4, cc = ch & 15; *(u32x4*)(Vl + ri * VS_LD + cc * 8) = sv[k]; }
                u32x2 yo[4];
#pragma unroll
                for (int nt = 0; nt < 4; ++nt) yo[nt] = yold[nt];
                __syncthreads();
                u32x2 vv[4];
                vt_issue((unsigned)(size_t)Vl + (unsigned)(((8 * g + (r >> 2)) * VS_LD + 16 * w + 4 * (r & 3)) * 2), vv);
                if (c + 1 < 36) issueQ(c + 1);
                vt_wait(vv);
                bf16x8 Vf[2], Vs[2];
#pragma unroll
                for (int t = 0; t < 2; ++t) {
                    const u32x4 vft = (u32x4){vv[2 * t].x, vv[2 * t].y, vv[2 * t + 1].x, vv[2 * t + 1].y};
                    Vf[t] = __builtin_bit_cast(bf16x8, vft);
                    const int j0 = 32 * t + 8 * g;
                    const float base = __builtin_amdgcn_exp2f((dir == 0 ? (float)(63 - j0) : (float)j0) * l2g);
                    const unsigned uu[4] = {vft.x, vft.y, vft.z, vft.w};
                    unsigned oo[4];
#pragma unroll
                    for (int e2 = 0; e2 < 4; ++e2) oo[e2] = cvt_pk_bf16(bf_lo(uu[e2]) * (base * ge[2 * e2]), bf_hi(uu[e2]) * (base * ge[2 * e2 + 1]));
                    Vs[t] = __builtin_bit_cast(bf16x8, (u32x4){oo[0], oo[1], oo[2], oo[3]});
                }
                const bool deadout = (lj == 1) && (s0 < 256);
                if (pass == 0 && !deadout) {
                    f32x4 sc[2] = {(f32x4){0.f, 0.f, 0.f, 0.f}, (f32x4){0.f, 0.f, 0.f, 0.f}};
                    const bf16_t* kp = Ks + (16 * jb + r) * KS_LD + 8 * g;
                    const bf16_t* qp0 = Qs + (32 * ih + r) * QS_LD + 8 * g;
                    bf16x8 ka[2], qb[2][2];
                    ka[0] = *(const bf16x8*)kp; qb[0][0] = *(const bf16x8*)qp0; qb[0][1] = *(const bf16x8*)(qp0 + 16 * QS_LD);
#pragma unroll
                    for (int t = 0; t < 8; ++t) {
                        if (t + 1 < 8) { ka[(t + 1) & 1] = *(const bf16x8*)(kp + 32 * (t + 1)); qb[(t + 1) & 1][0] = *(const bf16x8*)(qp0 + 32 * (t + 1)); qb[(t + 1) & 1][1] = *(const bf16x8*)(qp0 + 16 * QS_LD + 32 * (t + 1)); }
                        sc[0] = __builtin_amdgcn_mfma_f32_16x16x32_bf16(ka[t & 1], qb[t & 1][0], sc[0], 0, 0, 0);
                        sc[1] = __builtin_amdgcn_mfma_f32_16x16x32_bf16(ka[t & 1], qb[t & 1][1], sc[1], 0, 0, 0);
                        __builtin_amdgcn_sched_barrier(0);
                    }
#pragma unroll
                    for (int nt = 0; nt < 2; ++nt) { const int i = 32 * ih + 16 * nt + r; const int j0 = 16 * jb + 4 * g;
                        float pv[4];
#pragma unroll
                        for (int jj = 0; jj < 4; ++jj) { const int df = j0 + jj - i;
                            pv[jj] = sc[nt][jj] * __builtin_amdgcn_exp2f(df > 0 ? (float)df * l2gB : (float)(-df) * l2gF); }
                        u32x2 o; o.x = cvt_pk_bf16(pv[0], pv[1]); o.y = cvt_pk_bf16(pv[2], pv[3]);
                        *(u32x2*)(Ps + i * P_LD + j0) = o; }
                }
                if (c + 1 < 36) issueK(c + 1);
                f32x4 o1[4], o2[4];
#pragma unroll
                for (int nt = 0; nt < 4; ++nt) { o1[nt] = (f32x4){0.f, 0.f, 0.f, 0.f}; o2[nt] = (f32x4){0.f, 0.f, 0.f, 0.f}; }
                if (!deadout) {
                    if (pass == 0) { __syncthreads(); scan_bc<true>(Ps, Qs, r, g, Vf, S, o1, o2); }
                    else if (c > 0) scan_bc<false>(Ps, Qs, r, g, Vf, S, o1, o2);
                }
                if (c + 1 < 36) issueVY(c + 1);
                if (c < 35) {
                    u32x2 fa0[8], fa1[8];
                    const unsigned kaddr = (unsigned)(size_t)Ks + (unsigned)(((8 * g + (r >> 2)) * KS_LD + 4 * (r & 3)) * 2);
                    kt_issue<0>(kaddr, fa0);
                    kt_step<0, false>(kaddr, fa0, fa1, S, Vs, Gc);
                    kt_step<1, false>(kaddr, fa1, fa0, S, Vs, Gc);
                    kt_step<2, false>(kaddr, fa0, fa1, S, Vs, Gc);
                    kt_step<3, false>(kaddr, fa1, fa0, S, Vs, Gc);
                    kt_step<4, false>(kaddr, fa0, fa1, S, Vs, Gc);
                    kt_step<5, false>(kaddr, fa1, fa0, S, Vs, Gc);
                    kt_step<6, false>(kaddr, fa0, fa1, S, Vs, Gc);
                    kt_step<7, true>(kaddr, fa1, fa0, S, Vs, Gc);
                }
                if (!deadout)
#pragma unroll
                for (int nt = 0; nt < 4; ++nt) { const int i = 16 * nt + r;
                    const float qd = __builtin_amdgcn_exp2f((dir == 0 ? (float)(i + 1) : (float)(64 - i)) * l2g);
                    f32x4 yv = o1[nt] + o2[nt] * qd;
                    bf16_t* yp = (bf16_t*)((char*)(Y + (size_t)grow0 * 2048 + h * 512 + sl * 128 + 16 * w) + (size_t)nt * 65536 + vo_y);
                    if (pass == 1) { yv[0] += bf_lo(yo[nt].x); yv[1] += bf_hi(yo[nt].x); yv[2] += bf_lo(yo[nt].y); yv[3] += bf_hi(yo[nt].y); }
                    u32x2 o; o.x = cvt_pk_bf16(yv[0], yv[1]); o.y = cvt_pk_bf16(yv[2], yv[3]);
                    *(u32x2*)yp = o; }
                __syncthreads();
            }
        }
    }
}

__device__ __forceinline__ void gbar(unsigned* ctr, unsigned& target) {
    asm volatile("s_waitcnt vmcnt(0) lgkmcnt(0)" ::: "memory");
    __syncthreads();
    target += gridDim.x;
    if (threadIdx.x == 0) {
        __builtin_amdgcn_fence(__ATOMIC_RELEASE, "agent");
        asm volatile("s_waitcnt vmcnt(0)" ::: "memory");
        __hip_atomic_fetch_add(ctr, 1u, __ATOMIC_RELAXED, __HIP_MEMORY_SCOPE_AGENT);
        while (__hip_atomic_load(ctr, __ATOMIC_RELAXED, __HIP_MEMORY_SCOPE_AGENT) < target) __builtin_amdgcn_s_sleep(2);
        __builtin_amdgcn_fence(__ATOMIC_ACQUIRE, "agent");
        asm volatile("s_waitcnt vmcnt(0)" ::: "memory");
    }
    __syncthreads();
}

__global__ void __launch_bounds__(512, 2) mega(Params p) {
    extern __shared__ __attribute__((aligned(16))) unsigned char shm[];
    cg::grid_group grid = cg::this_grid();
    LAS unsigned char* lds = (LAS unsigned char*)shm;
    float* X = (float*)(p.ws + WS_X);
    unsigned char* R1 = p.ws + WS_R1;
    bf16_t* Y = (bf16_t*)(p.ws + WS_Y);
    bf16_t* H = (bf16_t*)((unsigned char*)p.out + OB_H);
    const bf16_t* Wb = (const bf16_t*)((unsigned char*)p.out + OB_W);
    const float* MOD = (const float*)((unsigned char*)p.out + OB_MOD);
    const f32x2* CS = (const f32x2*)((unsigned char*)p.out + OB_CS);
    const TileMap idm = {1 << 30, 0, 0};
    unsigned* bar = (unsigned*)(p.ws + WS_BAR); unsigned btarget = 0;

    phase0(p, (float*)shm);
    grid.sync();

    for (int layer = 0; layer < 4; ++layer) {
        const bool last = layer == 3;
        const bool use_ret = (layer & 1) == 0;
        const int lj = layer >> 1;
        const float* modl = MOD + (size_t)layer * 33 * 6144;
        const int r0 = last ? TCTX : 0;
        const TileMap rowmap = last ? TileMap{0, 0, 32} : idm;
        const int Mrows = last ? (TT - TCTX) : TT;
        const bool latpost = layer >= 2;
        const int r0p = latpost ? TCTX : 0;
        const TileMap rowmapp = latpost ? TileMap{0, 0, 32} : idm;
        const int Mrowsp = latpost ? (TT - TCTX) : TT;

        const float* Xc = layer == 0 ? p.ctx : X; const float* Xl = layer == 0 ? p.x - (size_t)TCTX * 1024 : X;
        norm_phase(Xc, Xl, H, p.norm1_w + layer * 1024, modl, 0, 1, r0, TT);
        gbar(bar, btarget);

        if (use_ret) {
            const bf16_t* Win = Wb + W_RETIN + (size_t)lj * 6144 * 1024;
            bf16_t* Qg = (bf16_t*)R1; bf16_t* Kg = Qg + (size_t)TH * 1024; bf16_t* VTg = Kg + (size_t)TH * 1024;
            for (int half = 0; half < 2; ++half) {
                const TileMap hm = {16, 16 * half, 32 + 128 * half};
                { Gemm g = {H, Win + (size_t)2048 * 1024, 1024, 1024, TH, 4096, 1024, hm, idm, 0};
                  EpiQK E = {Qg, Kg, VTg, CS, hm};
                  pg8::gemm_phase(lds, g, E); }
                gbar(bar, btarget);
                ret_phase(p, shm, lj, half);
                gbar(bar, btarget);
            }
            stats_phase(Y, (f32x2*)(p.ws + WS_ST), r0p);
            gbar(bar, btarget);
            { Gemm g = {H, Win, 1024, 1024, Mrowsp, 2048, 1024, rowmapp, idm, 0};
              EpiSiluGN E = {(bf16_t*)R1, rowmapp, Y, (const f32x2*)(p.ws + WS_ST), p.ret_gn_w + lj * 2048};
              pg8::gemm_phase(lds, g, E); }
            gbar(bar, btarget);
            { Gemm g = {(const bf16_t*)R1, Wb + W_RETOUT + (size_t)lj * 1024 * 2048, 2048, 2048, Mrowsp, 1024, 2048, rowmapp, idm, 0};
              EpiRes E = {X, Xc, Xl, modl, 2, nullptr, rowmapp};
              pg8::gemm_phase(lds, g, E); }
            gbar(bar, btarget);
        } else {
            pool_phase(H, (bf16_t*)R1, r0, TT);
            gbar(bar, btarget);
            { Gemm g = {(const bf16_t*)R1, Wb + W_POOL + (size_t)lj * 262144, 1024, 256, Mrows, 1024, 256, rowmap, idm, 512};
              EpiRes E = {X, X, X, modl, 2, p.pool_scale + lj * 1024, rowmap};
              pg8::gemm_phase(lds, g, E); }
            gbar(bar, btarget);
        }

        norm_phase(X, X, H, p.norm2_w + layer * 1024, modl, 3, 4, r0p, TT);
        gbar(bar, btarget);
        { Gemm g = {H, Wb + W_FFNIN + (size_t)layer * 5632 * 1024, 1024, 1024, Mrowsp, 5632, 1024, rowmapp, idm, 0};
          EpiSwiglu E = {(bf16_t*)R1, rowmapp};
          pg8::gemm_phase(lds, g, E); }
        gbar(bar, btarget);
        { Gemm g = {(const bf16_t*)R1, Wb + W_FFNOUT + (size_t)layer * 1024 * HID, HID, HID, Mrowsp, 1024, HID, rowmapp, idm, 0};
          EpiRes E = {X, X, X, modl, 5, nullptr, rowmapp};
          pg8::gemm_phase(lds, g, E); }
        gbar(bar, btarget);
    }
    final_norm_phase(X, p.out, p.final_norm_w);
}

extern "C" void kernel_launch(void* const* d_in, const int* in_sizes, int n_in, void* d_out, int out_size, void* d_ws, size_t ws_size, hipStream_t stream) {
    static int grid_blocks = 0;
    if (!grid_blocks) {
        if (ws_size < WS_END || n_in < 17) { fprintf(stderr, "kernel_launch: workspace too small (%zu < %zu) or n_in %d\n", ws_size, (size_t)WS_END, n_in); grid_blocks = -1; return; }
        int dev = 0, cus = 0, per_cu = 0;
        hipGetDevice(&dev);
        hipDeviceGetAttribute(&cus, hipDeviceAttributeMultiprocessorCount, dev);
        if (hipFuncSetAttribute((const void*)mega, hipFuncAttributeMaxDynamicSharedMemorySize, LDS_BYTES) != hipSuccess) { fprintf(stderr, "kernel_launch: hipFuncSetAttribute failed\n"); grid_blocks = -1; return; }
        hipOccupancyMaxActiveBlocksPerMultiprocessor(&per_cu, (const void*)mega, 512, LDS_BYTES);
        if (per_cu < 1) { fprintf(stderr, "kernel_launch: occupancy query returned %d\n", per_cu); per_cu = 1; }
        grid_blocks = cus * per_cu;
    }
    if (grid_blocks < 0) return;
    Params p{};
    p.x = (const float*)d_in[0]; p.c = (const float*)d_in[1]; p.ctx = (const float*)d_in[2]; p.c_ctx = (const float*)d_in[3];
    p.ada_w = (const float*)d_in[4]; p.ada_b = (const float*)d_in[5]; p.norm1_w = (const float*)d_in[6]; p.norm2_w = (const float*)d_in[7];
    p.ret_w_in = (const float*)d_in[8]; p.ret_log_decay = (const float*)d_in[9]; p.ret_gn_w = (const float*)d_in[10]; p.ret_w_out = (const float*)d_in[11];
    p.pool_w = (const float*)d_in[12]; p.pool_scale = (const float*)d_in[13]; p.ffn_w_in = (const float*)d_in[14]; p.ffn_w_out = (const float*)d_in[15];
    p.final_norm_w = (const float*)d_in[16];
    p.out = (float*)d_out; p.ws = (unsigned char*)d_ws;
    if (hipMemsetAsync((unsigned char*)d_ws + WS_BAR, 0, 256, stream) != hipSuccess) { fprintf(stderr, "kernel_launch: memset failed\n"); return; }
    void* args[] = {&p};
    hipError_t e = hipLaunchCooperativeKernel((const void*)mega, dim3(grid_blocks), dim3(512), args, LDS_BYTES, stream);
    if (e != hipSuccess) fprintf(stderr, "cooperative launch failed: %s (grid %d)\n", hipGetErrorString(e), grid_blocks);
}
```

```cpp
#include <hip/hip_runtime.h>
#include <hip/hip_cooperative_groups.h>
#include <cstdio>
namespace cg = cooperative_groups;

#define LAS __attribute__((address_space(3)))
typedef unsigned short bf16_t;
typedef short bf16x8 __attribute__((ext_vector_type(8)));
typedef float f32x4 __attribute__((ext_vector_type(4)));
typedef float f32x2 __attribute__((ext_vector_type(2)));
typedef unsigned u32x4 __attribute__((ext_vector_type(4)));
typedef unsigned u32x2 __attribute__((ext_vector_type(2)));

constexpr int DM = 1024, NB = 32, SEQ = 2048, CTXL = 256, HID = 2816;
constexpr int TCTX = NB * CTXL;
constexpr int TT = TCTX + NB * SEQ;
constexpr int TH = TT / 2;
constexpr int LDS_BYTES = 135168;

constexpr size_t WS_X = 0;
constexpr size_t WS_R1 = 301989888ull;
constexpr size_t WS_Y = WS_R1 + 377487360ull;
constexpr size_t WS_BAR = WS_Y + 301989888ull;
constexpr size_t WS_ST = WS_BAR + 256;
constexpr size_t WS_END = WS_ST + 2359296ull;
constexpr size_t OB_H = 0;
constexpr size_t OB_W = 150994944ull;
constexpr size_t OB_MOD = 254803968ull;
constexpr size_t OB_CS = 258048000ull;
constexpr size_t W_RETIN = 0, W_RETOUT = 12582912ull, W_POOL = 16777216ull, W_FFNIN = 17301504ull, W_FFNOUT = 40370176ull;

struct Params {
    const float *x, *c, *ctx, *c_ctx, *ada_w, *ada_b, *norm1_w, *norm2_w, *ret_w_in, *ret_log_decay, *ret_gn_w, *ret_w_out, *pool_w, *pool_scale, *ffn_w_in, *ffn_w_out, *final_norm_w;
    float* out; unsigned char* ws;
};

__device__ __forceinline__ unsigned cvt_pk_bf16(float lo, float hi) { unsigned r; asm("v_cvt_pk_bf16_f32 %0, %1, %2" : "=v"(r) : "v"(lo), "v"(hi)); return r; }
__device__ __forceinline__ float bf_lo(unsigned u) { return __uint_as_float(u << 16); }
__device__ __forceinline__ float bf_hi(unsigned u) { return __uint_as_float(u & 0xffff0000u); }
__device__ __forceinline__ int opaque_tid() { int t = threadIdx.x; asm volatile("" : "+v"(t)); return t; }
__device__ __forceinline__ float silu_f(float v) { return v * __builtin_amdgcn_rcpf(1.0f + __expf(-v)); }
__device__ __forceinline__ f32x4 silu4(f32x4 v) {
    f32x4 e, r;
#pragma unroll
    for (int j = 0; j < 4; ++j) e[j] = __builtin_amdgcn_exp2f(v[j] * -1.4426950408889634f);
#pragma unroll
    for (int j = 0; j < 4; ++j) r[j] = __builtin_amdgcn_rcpf(1.0f + e[j]);
    return v * r;
}

namespace pg8 {
constexpr int BM = 256, BK = 64, HALF = 128, HTB = HALF * BK * 2, STAGE_BYTES = 8 * HTB, NXCD = 8, WGM = 4;
__host__ __device__ __forceinline__ int lds_byte(int r, int c) { const int st = (r >> 4) * 2 + (c >> 5), rr = r & 15, cc = c & 31, ob = rr * 64 + cc * 2; return st * 1024 + (ob ^ (((ob >> 9) & 1) << 5)); }
__host__ __device__ __forceinline__ void stage_rc(int b, int& R, int& C) { const int st = b / 1024, sb = b % 1024, swz = sb ^ (((sb >> 9) & 1) << 5); R = (st >> 1) * 16 + swz / 64; C = (st & 1) * 32 + (swz % 64) / 2; }
__host__ __device__ __forceinline__ int perm32(int rho) { const int n = rho >> 4, i = rho & 15; return 8 * (i >> 2) + 4 * n + (i & 3); }

struct Unit { int pm, pn; };
struct TileMap { int nctx, ctx0, lat0; __device__ __forceinline__ int src(int t) const { return t < nctx ? ctx0 + t : lat0 + (t - nctx); } };
struct Gemm { const bf16_t* A; const bf16_t* Bt; int lda, ldb, M, N, K; TileMap mapA, mapB; int a_pn_step; };

struct StaticOrder {
    int nM, nN, nwg, G, c;
    __device__ void init(int M, int N, int G_, int c_) { nM = M / BM; nN = N / BM; nwg = nM * nN; G = G_; c = c_; }
    __device__ bool next(int i, Unit& u) const {
        const long L = (long)i * G + c; if (L >= nwg) return false;
        int wgid = (int)L; { const int q = nwg / NXCD, r = nwg % NXCD, xcd = wgid % NXCD, off = wgid / NXCD; wgid = (xcd < r ? xcd * (q + 1) : r * (q + 1) + (xcd - r) * q) + off; }
        const int nig = WGM * nN, gid = wgid / nig, fm = gid * WGM, gsz = (nM - fm) < WGM ? (nM - fm) : WGM;
        u.pm = fm + ((wgid % nig) % gsz); u.pn = (wgid % nig) / gsz; return true;
    }
};

template <class Epi>
__device__ __forceinline__ void gemm_phase(LAS unsigned char* lds, const Gemm g, const Epi& E) {
    const int tid = opaque_tid(), wid = __builtin_amdgcn_readfirstlane(tid >> 6), lane = tid & 63, wr = wid >> 2, wc = wid & 3, fr = lane & 15, fq = lane >> 4;
    const int K = g.K, nt = K / BK;
    StaticOrder S; S.init(g.M, g.N, (int)gridDim.x, (int)blockIdx.x);
    unsigned voffA[2], voffB[2];
#pragma unroll
    for (int i = 0; i < 2; ++i) { int R, C; stage_rc(tid * 16 + i * 8192, R, C); const int Rb = Epi::PERM ? ((R & ~31) + perm32(R & 31)) : R;
        voffA[i] = (unsigned)(R * g.lda + C) * 2u; voffB[i] = (unsigned)(Rb * g.ldb + C) * 2u; }
    const size_t kstep = (size_t)(BK * 2);
    const size_t hstepA = (size_t)HALF * g.lda * 2, hstepB = (size_t)HALF * g.ldb * 2;
    const size_t tstepA = 2 * hstepA, tstepB = 2 * hstepB;
    const unsigned ldsw = (unsigned)wid * 1024u;
    const int aoff = lds_byte(wr * 64 + fr, fq * 8), boff = lds_byte(wc * 32 + fr, fq * 8);
#define PG8_SA(b, h) (((b) * 2 + (h)) * HTB)
#define PG8_SB(b, h) ((4 + (b) * 2 + (h)) * HTB)
#define PG8_STAGE(bufoff, gbase, voff) do { _Pragma("unroll") for (int _i = 0; _i < 2; ++_i) \
        __builtin_amdgcn_global_load_lds((const unsigned*)((const char*)(gbase) + (voff)[_i]), (LAS unsigned*)(lds + (bufoff) + ldsw + _i * 8192), 16, 0, 0); } while (0)
#define PG8_LDA(dst, b, h) do { _Pragma("unroll") for (int m = 0; m < 4; ++m) _Pragma("unroll") for (int k = 0; k < 2; ++k) dst[m][k] = *(const LAS bf16x8*)(lds + PG8_SA(b, h) + aoff + m * 2048 + k * 1024); } while (0)
#define PG8_LDB(dst, b, h) do { _Pragma("unroll") for (int n = 0; n < 2; ++n) _Pragma("unroll") for (int k = 0; k < 2; ++k) dst[n][k] = *(const LAS bf16x8*)(lds + PG8_SB(b, h) + boff + n * 2048 + k * 1024); } while (0)
#define PG8_MMA(ai, bj, At, Bt) do { __builtin_amdgcn_s_setprio(1); _Pragma("unroll") for (int m = 0; m < 4; ++m) _Pragma("unroll") for (int n = 0; n < 2; ++n) _Pragma("unroll") for (int k = 0; k < 2; ++k) \
        acc[ai][bj][m][n] = __builtin_amdgcn_mfma_f32_16x16x32_bf16(Bt[n][k], At[m][k], acc[ai][bj][m][n], 0, 0, 0); __builtin_amdgcn_s_setprio(0); } while (0)
#define PG8_WAIT_V(n) asm volatile("s_waitcnt vmcnt(" #n ")" ::: "memory")
#define PG8_WAIT_L(n) asm volatile("s_waitcnt lgkmcnt(" #n ")" ::: "memory")
#define PG8_BAR __builtin_amdgcn_s_barrier()
#define PG8_SCHED __builtin_amdgcn_sched_barrier(0)
    Unit cur, nxt; int ui = 0;
    if (!S.next(0, cur)) return;
    f32x4 acc[2][2][4][2];
#pragma unroll
    for (int a = 0; a < 2; ++a)
#pragma unroll
        for (int b = 0; b < 2; ++b)
#pragma unroll
            for (int m = 0; m < 4; ++m)
#pragma unroll
                for (int n = 0; n < 2; ++n) acc[a][b][m][n] = (f32x4){0.f, 0.f, 0.f, 0.f};
    bf16x8 At[4][2], B0[2][2], B1[2][2];
    const char* cA = (const char*)g.A + (size_t)g.mapA.src(cur.pm) * tstepA + (size_t)cur.pn * g.a_pn_step;
    const char* cB = (const char*)g.Bt + (size_t)g.mapB.src(cur.pn) * tstepB;
    PG8_STAGE(PG8_SB(0, 0), cB, voffB); PG8_STAGE(PG8_SA(0, 0), cA, voffA); PG8_STAGE(PG8_SB(0, 1), cB + hstepB, voffB); PG8_STAGE(PG8_SA(0, 1), cA + hstepA, voffA);
    if (wr == 1) PG8_BAR;
    PG8_WAIT_V(4); PG8_BAR;
    PG8_STAGE(PG8_SB(1, 0), cB + kstep, voffB); PG8_STAGE(PG8_SA(1, 0), cA + kstep, voffA); PG8_STAGE(PG8_SB(1, 1), cB + hstepB + kstep, voffB);
    PG8_WAIT_V(6); PG8_BAR;
    for (;;) {
        const bool has_next = S.next(ui + 1, nxt);
        const char* nA = has_next ? (const char*)g.A + (size_t)g.mapA.src(nxt.pm) * tstepA + (size_t)nxt.pn * g.a_pn_step : cA;
        const char* nB = has_next ? (const char*)g.Bt + (size_t)g.mapB.src(nxt.pn) * tstepB : cB;
        for (int t = 0; t < nt; t += 2) {
            const bool last = (t == nt - 2);
            const char* a1 = cA + (size_t)(t + 1) * kstep;
            const char* a2 = last ? nA : cA + (size_t)(t + 2) * kstep; const char* b2 = last ? nB : cB + (size_t)(t + 2) * kstep;
            const char* a3 = a2 + kstep; const char* b3 = b2 + kstep;
            PG8_LDB(B0, 0, 0); PG8_SCHED; PG8_LDA(At, 0, 0); PG8_STAGE(PG8_SA(1, 1), a1 + hstepA, voffA);
            PG8_WAIT_L(8); PG8_BAR; PG8_WAIT_L(0); PG8_MMA(0, 0, At, B0); PG8_BAR; PG8_SCHED;
            PG8_LDB(B1, 0, 1); PG8_STAGE(PG8_SB(0, 0), b2, voffB);
            PG8_BAR; PG8_WAIT_L(0); PG8_MMA(0, 1, At, B1); PG8_BAR;
            PG8_LDA(At, 0, 1); PG8_STAGE(PG8_SA(0, 0), a2, voffA);
            PG8_BAR; PG8_WAIT_L(0); PG8_MMA(1, 0, At, B0); PG8_BAR; PG8_SCHED;
            PG8_STAGE(PG8_SB(0, 1), b2 + hstepB, voffB);
            PG8_WAIT_V(6); PG8_BAR; PG8_MMA(1, 1, At, B1); PG8_BAR;
            PG8_LDB(B0, 1, 0); PG8_SCHED; PG8_LDA(At, 1, 0); PG8_STAGE(PG8_SA(0, 1), a2 + hstepA, voffA);
            PG8_WAIT_L(8); PG8_BAR; PG8_WAIT_L(0); PG8_MMA(0, 0, At, B0); PG8_BAR; PG8_SCHED;
            PG8_LDB(B1, 1, 1); PG8_STAGE(PG8_SB(1, 0), b3, voffB);
            PG8_BAR; PG8_WAIT_L(0); PG8_MMA(0, 1, At, B1); PG8_BAR;
            PG8_LDA(At, 1, 1); PG8_STAGE(PG8_SA(1, 0), a3, voffA);
            PG8_BAR; PG8_WAIT_L(0); PG8_MMA(1, 0, At, B0); PG8_BAR; PG8_SCHED;
            PG8_STAGE(PG8_SB(1, 1), b3 + hstepB, voffB);
            PG8_WAIT_V(6); PG8_BAR; PG8_MMA(1, 1, At, B1); PG8_BAR;
        }
        E(acc, cur, wr, wc, fr, fq);
        if (!has_next) break;
#pragma unroll
        for (int a = 0; a < 2; ++a)
#pragma unroll
            for (int b = 0; b < 2; ++b)
#pragma unroll
                for (int m = 0; m < 4; ++m)
#pragma unroll
                    for (int n = 0; n < 2; ++n) acc[a][b][m][n] = (f32x4){0.f, 0.f, 0.f, 0.f};
        cur = nxt; cA = nA; cB = nB; ++ui;
    }
    PG8_WAIT_V(0);
    if (wr == 0) PG8_BAR;
    PG8_BAR;
#undef PG8_SA
#undef PG8_SB
#undef PG8_STAGE
#undef PG8_LDA
#undef PG8_LDB
#undef PG8_MMA
#undef PG8_WAIT_V
#undef PG8_WAIT_L
#undef PG8_BAR
#undef PG8_SCHED
}
}
using pg8::Unit; using pg8::TileMap; using pg8::Gemm;

typedef f32x4 AccT[2][2][4][2];

struct EpiRes {
    static constexpr bool PERM = false;
    float* X; const float* Xc; const float* Xl; const float* modl; int gi; const float* scale; TileMap mapA;
    __device__ __forceinline__ void operator()(const AccT& acc, const Unit& u, int wr, int wc, int fr, int fq) const {
        asm volatile("" : "+v"(fr), "+v"(fq));
        const int gpm = mapA.src(u.pm);
        const int mb = gpm < 32 ? 32 : (gpm - 32) >> 3;
        const int row0 = gpm * 256 + wr * 64 + fr, col0 = u.pn * 256 + wc * 32 + 4 * fq;
        const float* gp = modl + ((size_t)mb * 6 + gi) * 1024;
        f32x4 gv[2][2];
#pragma unroll
        for (int bj = 0; bj < 2; ++bj)
#pragma unroll
            for (int n = 0; n < 2; ++n) { gv[bj][n] = *(const f32x4*)(gp + col0 + bj * 128 + n * 16); if (scale) gv[bj][n] = gv[bj][n] * *(const f32x4*)(scale + col0 + bj * 128 + n * 16); }
        const float* sbase = (gpm < 32 ? Xc : Xl) + (size_t)row0 * 1024 + col0;
#pragma unroll
        for (int ai = 0; ai < 2; ++ai) {
            f32x4 xo[4][2][2];
#pragma unroll
            for (int m = 0; m < 4; ++m)
#pragma unroll
                for (int bj = 0; bj < 2; ++bj)
#pragma unroll
                    for (int n = 0; n < 2; ++n) xo[m][bj][n] = *(const f32x4*)(sbase + (size_t)(ai * 128 + m * 16) * 1024 + bj * 128 + n * 16);
            __builtin_amdgcn_sched_barrier(0);
#pragma unroll
            for (int m = 0; m < 4; ++m) { float* rowp = X + (size_t)(row0 + ai * 128 + m * 16) * 1024 + col0;
#pragma unroll
                for (int bj = 0; bj < 2; ++bj)
#pragma unroll
                    for (int n = 0; n < 2; ++n) *(f32x4*)(rowp + bj * 128 + n * 16) = xo[m][bj][n] + gv[bj][n] * acc[ai][bj][m][n]; }
            __builtin_amdgcn_sched_barrier(0);
        }
    }
};

struct EpiQK {
    static constexpr bool PERM = true;
    bf16_t* Q; bf16_t* Kk; bf16_t* Vv; const f32x2* cs; TileMap mapA;
    __device__ __forceinline__ void operator()(const AccT& acc, const Unit& u, int wr, int wc, int fr, int fq) const {
        asm volatile("" : "+v"(fr), "+v"(fq));
        const int gpm = mapA.src(u.pm);
        const bool isq = u.pn < 4, isv = u.pn >= 8;
        const bool lat = gpm >= 32 && !isv;
        bf16_t* base = isq ? Q : (isv ? Vv + (size_t)(u.pn - 8) * 256 : Kk);
        const int hh = isv ? 0 : (u.pn & 3);
        const int ldo = isv ? 2048 : 1024;
        const float osc = isq ? 0.0625f : 1.0f;
        const int p0 = 16 * wc + 4 * fq;
        f32x4 ctR[2][2], ctC[4][2];
        if (lat) {
#pragma unroll
            for (int ai = 0; ai < 2; ++ai) { const int pr = ((gpm - 32) * 4 + 2 * ai + wr) & 31;
                ctR[ai][0] = *(const f32x4*)(cs + pr * 64 + p0); ctR[ai][1] = *(const f32x4*)(cs + pr * 64 + p0 + 2); }
#pragma unroll
            for (int m = 0; m < 4; ++m) { const int pc = m * 16 + fr;
                ctC[m][0] = *(const f32x4*)(cs + pc * 64 + p0); ctC[m][1] = *(const f32x4*)(cs + pc * 64 + p0 + 2); }
        }
        __builtin_amdgcn_sched_barrier(0);
#pragma unroll
        for (int ai = 0; ai < 2; ++ai)
#pragma unroll
            for (int m = 0; m < 4; ++m) {
                const int rl = ai * 128 + wr * 64 + m * 16 + fr;
                bf16_t* rowp = base + (size_t)(u.pm * 256 + rl) * ldo + hh * 256 + wc * 32 + 8 * fq;
#pragma unroll
                for (int bj = 0; bj < 2; ++bj) {
                    f32x4 v0 = acc[ai][bj][m][0], v1 = acc[ai][bj][m][1];
                    if (lat) {
                        const f32x4 c01 = bj ? ctC[m][0] : ctR[ai][0], c23 = bj ? ctC[m][1] : ctR[ai][1];
                        f32x4 r0, r1;
                        r0[0] = v0[0] * c01[0] - v0[1] * c01[1]; r0[1] = v0[0] * c01[1] + v0[1] * c01[0];
                        r0[2] = v0[2] * c01[2] - v0[3] * c01[3]; r0[3] = v0[2] * c01[3] + v0[3] * c01[2];
                        r1[0] = v1[0] * c23[0] - v1[1] * c23[1]; r1[1] = v1[0] * c23[1] + v1[1] * c23[0];
                        r1[2] = v1[2] * c23[2] - v1[3] * c23[3]; r1[3] = v1[2] * c23[3] + v1[3] * c23[2];
                        v0 = r0; v1 = r1;
                    }
                    v0 = v0 * osc; v1 = v1 * osc;
                    u32x4 w; w.x = cvt_pk_bf16(v0[0], v0[1]); w.y = cvt_pk_bf16(v0[2], v0[3]); w.z = cvt_pk_bf16(v1[0], v1[1]); w.w = cvt_pk_bf16(v1[2], v1[3]);
                    *(u32x4*)(rowp + bj * 128) = w;
                }
            }
    }
};

struct EpiSiluGN {
    static constexpr bool PERM = true;
    bf16_t* A2; TileMap mapA; const bf16_t* Y; const f32x2* ST; const float* gnw;
    __device__ __forceinline__ void operator()(const AccT& acc, const Unit& u, int wr, int wc, int fr, int fq) const {
        asm volatile("" : "+v"(fr), "+v"(fq));
        const int row0 = mapA.src(u.pm) * 256 + wr * 64 + fr, col0 = u.pn * 256 + wc * 32 + 8 * fq;
        const int hd = u.pn >> 1;
        f32x4 gw[2][2]; f32x2 st[2][4];
#pragma unroll
        for (int bj = 0; bj < 2; ++bj) { gw[bj][0] = *(const f32x4*)(gnw + col0 + bj * 128); gw[bj][1] = *(const f32x4*)(gnw + col0 + bj * 128 + 4); }
#pragma unroll
        for (int ai = 0; ai < 2; ++ai)
#pragma unroll
            for (int m = 0; m < 4; ++m) st[ai][m] = ST[(size_t)(row0 + ai * 128 + m * 16) * 4 + hd];
#pragma unroll
        for (int ai = 0; ai < 2; ++ai) {
            u32x4 yv[4][2];
#pragma unroll
            for (int m = 0; m < 4; ++m)
#pragma unroll
                for (int bj = 0; bj < 2; ++bj) yv[m][bj] = *(const u32x4*)(Y + (size_t)(row0 + ai * 128 + m * 16) * 2048 + col0 + bj * 128);
            __builtin_amdgcn_sched_barrier(0);
#pragma unroll
            for (int m = 0; m < 4; ++m) { bf16_t* rowp = A2 + (size_t)(row0 + ai * 128 + m * 16) * 2048 + col0;
                const float mu = st[ai][m][0], rs = st[ai][m][1];
#pragma unroll
                for (int bj = 0; bj < 2; ++bj) { const f32x4 v0 = acc[ai][bj][m][0], v1 = acc[ai][bj][m][1]; const u32x4 yw = yv[m][bj];
                    const f32x4 y0 = (f32x4){bf_lo(yw.x), bf_hi(yw.x), bf_lo(yw.y), bf_hi(yw.y)}, y1 = (f32x4){bf_lo(yw.z), bf_hi(yw.z), bf_lo(yw.w), bf_hi(yw.w)};
                    const f32x4 n0 = (y0 - mu) * rs * gw[bj][0], n1 = (y1 - mu) * rs * gw[bj][1];
                    const f32x4 s0 = silu4(v0) * n0, s1 = silu4(v1) * n1;
                    u32x4 w; w.x = cvt_pk_bf16(s0[0], s0[1]); w.y = cvt_pk_bf16(s0[2], s0[3]); w.z = cvt_pk_bf16(s1[0], s1[1]); w.w = cvt_pk_bf16(s1[2], s1[3]);
                    *(u32x4*)(rowp + bj * 128) = w; } }
            __builtin_amdgcn_sched_barrier(0);
        }
    }
};

struct EpiSwiglu {
    static constexpr bool PERM = true;
    bf16_t* U; TileMap mapA;
    __device__ __forceinline__ void operator()(const AccT& acc, const Unit& u, int wr, int wc, int fr, int fq) const {
        asm volatile("" : "+v"(fr), "+v"(fq));
        const int gpm = mapA.src(u.pm);
        const int row0 = gpm * 256 + wr * 64 + fr, col0 = u.pn * 128 + wc * 32 + 8 * fq;
#pragma unroll
        for (int ai = 0; ai < 2; ++ai)
#pragma unroll
            for (int m = 0; m < 4; ++m) { bf16_t* rowp = U + (size_t)(row0 + ai * 128 + m * 16) * HID + col0;
                const f32x4 s0 = silu4(acc[ai][0][m][0]) * acc[ai][1][m][0], s1 = silu4(acc[ai][0][m][1]) * acc[ai][1][m][1];
                u32x4 w; w.x = cvt_pk_bf16(s0[0], s0[1]); w.y = cvt_pk_bf16(s0[2], s0[3]); w.z = cvt_pk_bf16(s1[0], s1[1]); w.w = cvt_pk_bf16(s1[2], s1[3]);
                *(u32x4*)rowp = w; }
    }
};

__device__ void norm_phase(const float* Xc, const float* Xl, bf16_t* H, const float* nw, const float* modl, int shi, int sci, int r0, int r1) {
    const int tid_ = opaque_tid(); const int wid = tid_ >> 6, lane = tid_ & 63;
    for (int row = r0 + (blockIdx.x * 8 + wid) * 4; row < r1; row += gridDim.x * 32) {
        const float* xp = (row < TCTX ? Xc : Xl) + (size_t)row * 1024 + lane * 4;
        f32x4 v[4][4]; float ss[4];
#pragma unroll
        for (int u = 0; u < 4; ++u)
#pragma unroll
            for (int q = 0; q < 4; ++q) v[u][q] = *(const f32x4*)(xp + u * 1024 + q * 256);
#pragma unroll
        for (int u = 0; u < 4; ++u) { float a = 0.f;
#pragma unroll
            for (int q = 0; q < 4; ++q) a += v[u][q][0] * v[u][q][0] + v[u][q][1] * v[u][q][1] + v[u][q][2] * v[u][q][2] + v[u][q][3] * v[u][q][3];
            ss[u] = a; }
#pragma unroll
        for (int o = 32; o >= 1; o >>= 1)
#pragma unroll
            for (int u = 0; u < 4; ++u) ss[u] += __int_as_float(__builtin_amdgcn_ds_bpermute((lane ^ o) << 2, __float_as_int(ss[u])));
        const int mb = row < TCTX ? 32 : (row - TCTX) >> 11;
        const float* shp = modl + ((size_t)mb * 6 + shi) * 1024; const float* scp = modl + ((size_t)mb * 6 + sci) * 1024;
#pragma unroll
        for (int q = 0; q < 4; ++q) { const int c = q * 256 + lane * 4;
            const f32x4 w = *(const f32x4*)(nw + c), sh = *(const f32x4*)(shp + c), sc = *(const f32x4*)(scp + c);
            const f32x4 wm = w * (sc + 1.0f);
#pragma unroll
            for (int u = 0; u < 4; ++u) { const float rstd = rsqrtf(ss[u] * (1.0f / 1024.0f) + 1e-6f);
                const f32x4 h = (v[u][q] * rstd) * wm + sh;
                u32x2 o; o.x = cvt_pk_bf16(h[0], h[1]); o.y = cvt_pk_bf16(h[2], h[3]);
                *(u32x2*)(H + (size_t)(row + u) * 1024 + c) = o; } }
    }
}

__device__ void final_norm_phase(const float* X, float* out, const float* nw) {
    const int tid_ = opaque_tid(); const int wid = tid_ >> 6, lane = tid_ & 63;
    for (int row = TCTX + (blockIdx.x * 8 + wid) * 4; row < TT; row += gridDim.x * 32) {
        const float* xp = X + (size_t)row * 1024 + lane * 4;
        f32x4 v[4][4]; float ss[4];
#pragma unroll
        for (int u = 0; u < 4; ++u)
#pragma unroll
            for (int q = 0; q < 4; ++q) v[u][q] = *(const f32x4*)(xp + u * 1024 + q * 256);
#pragma unroll
        for (int u = 0; u < 4; ++u) { float a = 0.f;
#pragma unroll
            for (int q = 0; q < 4; ++q) a += v[u][q][0] * v[u][q][0] + v[u][q][1] * v[u][q][1] + v[u][q][2] * v[u][q][2] + v[u][q][3] * v[u][q][3];
            ss[u] = a; }
#pragma unroll
        for (int o = 32; o >= 1; o >>= 1)
#pragma unroll
            for (int u = 0; u < 4; ++u) ss[u] += __int_as_float(__builtin_amdgcn_ds_bpermute((lane ^ o) << 2, __float_as_int(ss[u])));
#pragma unroll
        for (int q = 0; q < 4; ++q) { const int c = q * 256 + lane * 4; const f32x4 w = *(const f32x4*)(nw + c);
#pragma unroll
            for (int u = 0; u < 4; ++u) { const float rstd = rsqrtf(ss[u] * (1.0f / 1024.0f) + 1e-6f);
                *(f32x4*)(out + (size_t)(row + u - TCTX) * 1024 + c) = (v[u][q] * rstd) * w; } }
    }
}

template <int HW>
__device__ __forceinline__ void pool_item(const bf16_t* H, bf16_t* Dd, int row, int c) {
    int sb, L, t;
    if (row < TCTX) { sb = row & ~255; L = 256; t = row & 255; } else { sb = TCTX + ((row - TCTX) & ~2047); L = 2048; t = (row - TCTX) & 2047; }
    u32x4 wv[2 * HW];
#pragma unroll
    for (int k = 0; k < 2 * HW; ++k) { const int uu = t - HW + k; const bool ok = uu >= 0 && uu < L;
        wv[k] = ok ? *(const u32x4*)(H + (size_t)(sb + uu) * 1024 + c) : (u32x4){0u, 0u, 0u, 0u}; }
    float s[8];
#pragma unroll
    for (int j = 0; j < 8; ++j) s[j] = 0.f;
#pragma unroll
    for (int k = 0; k < 2 * HW; ++k) { const u32x4 w = wv[k];
        s[0] += bf_lo(w.x); s[1] += bf_hi(w.x); s[2] += bf_lo(w.y); s[3] += bf_hi(w.y); s[4] += bf_lo(w.z); s[5] += bf_hi(w.z); s[6] += bf_lo(w.w); s[7] += bf_hi(w.w); }
    const int lo = max(t - HW, 0), hi = min(t + HW, L);
    const float inv = 1.0f / (float)(hi - lo);
    const u32x4 w = wv[HW];
    u32x4 o;
    o.x = cvt_pk_bf16(s[0] * inv - bf_lo(w.x), s[1] * inv - bf_hi(w.x)); o.y = cvt_pk_bf16(s[2] * inv - bf_lo(w.y), s[3] * inv - bf_hi(w.y));
    o.z = cvt_pk_bf16(s[4] * inv - bf_lo(w.z), s[5] * inv - bf_hi(w.z)); o.w = cvt_pk_bf16(s[6] * inv - bf_lo(w.w), s[7] * inv - bf_hi(w.w));
    *(u32x4*)(Dd + (size_t)row * 1024 + c) = o;
}
__device__ void pool_phase(const bf16_t* H, bf16_t* Dd, int r0, int r1) {
    const int tid_ = opaque_tid(); const int wid = tid_ >> 6, lane = tid_ & 63;
    const int nw = (r1 - r0) * 2;
    for (int it = blockIdx.x * 8 + wid; it < nw; it += gridDim.x * 8) {
        const int gi = it & 3, row = r0 + (it >> 2) * 2 + (lane >> 5), c = gi * 256 + (lane & 31) * 8;
        if (gi == 0) pool_item<1>(H, Dd, row, c); else if (gi == 1) pool_item<2>(H, Dd, row, c); else if (gi == 2) pool_item<4>(H, Dd, row, c); else pool_item<8>(H, Dd, row, c);
    }
}

__device__ void stats_phase(const bf16_t* Y, f32x2* ST, int r0) {
    const int tid_ = opaque_tid(); const int wid = tid_ >> 6, lane = tid_ & 63;
    for (int row = r0 + blockIdx.x * 8 + wid; row < TT; row += gridDim.x * 8) {
        const size_t off = (size_t)row * 2048 + lane * 8;
        u32x4 yw[4];
#pragma unroll
        for (int hh = 0; hh < 4; ++hh) yw[hh] = *(const u32x4*)(Y + off + hh * 512);
        float y[4][8], sm[4], vq[4];
#pragma unroll
        for (int hh = 0; hh < 4; ++hh) { y[hh][0] = bf_lo(yw[hh].x); y[hh][1] = bf_hi(yw[hh].x); y[hh][2] = bf_lo(yw[hh].y); y[hh][3] = bf_hi(yw[hh].y); y[hh][4] = bf_lo(yw[hh].z); y[hh][5] = bf_hi(yw[hh].z); y[hh][6] = bf_lo(yw[hh].w); y[hh][7] = bf_hi(yw[hh].w);
            float a = 0.f;
#pragma unroll
            for (int j = 0; j < 8; ++j) a += y[hh][j];
            sm[hh] = a; }
#pragma unroll
        for (int o = 32; o >= 1; o >>= 1)
#pragma unroll
            for (int hh = 0; hh < 4; ++hh) sm[hh] += __int_as_float(__builtin_amdgcn_ds_bpermute((lane ^ o) << 2, __float_as_int(sm[hh])));
#pragma unroll
        for (int hh = 0; hh < 4; ++hh) { const float mu = sm[hh] * (1.0f / 512.0f); float a = 0.f; sm[hh] = mu;
#pragma unroll
            for (int j = 0; j < 8; ++j) { const float d = y[hh][j] - mu; a += d * d; }
            vq[hh] = a; }
#pragma unroll
        for (int o = 32; o >= 1; o >>= 1)
#pragma unroll
            for (int hh = 0; hh < 4; ++hh) vq[hh] += __int_as_float(__builtin_amdgcn_ds_bpermute((lane ^ o) << 2, __float_as_int(vq[hh])));
        if (lane < 4) { const float mu = lane == 0 ? sm[0] : (lane == 1 ? sm[1] : (lane == 2 ? sm[2] : sm[3])); const float v = lane == 0 ? vq[0] : (lane == 1 ? vq[1] : (lane == 2 ? vq[2] : vq[3]));
            ST[(size_t)row * 4 + lane] = (f32x2){mu, rsqrtf(v * (1.0f / 512.0f) + 1e-5f)}; }
    }
}

__device__ __forceinline__ int perm_qk(int c) { const int hh = c >> 8, hf = (c >> 7) & 1, dd = c & 127; return hh * 256 + hf * 128 + (dd & 1) * 64 + (dd >> 1); }

__device__ void conv_tile(const float* src, int srcN, bf16_t* dst, int K, int n0, int k0, int maptype, float* lds) {
    const int tid = opaque_tid();
    {
        const int kk = tid >> 6, nn = tid & 63, np = n0 + nn;
        int sc;
        if (maptype == 0) sc = np;
        else if (maptype == 1) sc = np < 2048 ? 4096 + np : (np < 3072 ? perm_qk(np - 2048) : (np < 4096 ? 1024 + perm_qk(np - 3072) : 2048 + (np - 4096)));
        else sc = ((np >> 7) & 1) * HID + (np >> 8) * 128 + (np & 127);
        float v[16];
#pragma unroll
        for (int ps = 0; ps < 16; ++ps) v[ps] = src[(size_t)(k0 + kk + 8 * ps) * srcN + sc];
#pragma unroll
        for (int ps = 0; ps < 16; ++ps) lds[(kk + 8 * ps) * 65 + nn] = v[ps];
    }
    __syncthreads();
    {
        const int nn = tid >> 3, kc = tid & 7;
#pragma unroll
        for (int hh = 0; hh < 2; ++hh) {
            float v[8];
#pragma unroll
            for (int e = 0; e < 8; ++e) v[e] = lds[(64 * hh + 8 * kc + e) * 65 + nn];
            u32x4 w; w.x = cvt_pk_bf16(v[0], v[1]); w.y = cvt_pk_bf16(v[2], v[3]); w.z = cvt_pk_bf16(v[4], v[5]); w.w = cvt_pk_bf16(v[6], v[7]);
            *(u32x4*)(dst + (size_t)(n0 + nn) * K + k0 + 64 * hh + 8 * kc) = w;
        }
    }
    __syncthreads();
}

__device__ void phase0(const Params& p, float* lds) {
    const int tid = opaque_tid(), wid = tid >> 6, lane = tid & 63;
    float* X = (float*)(p.ws + WS_X);
    bf16_t* Wb = (bf16_t*)((unsigned char*)p.out + OB_W);
    float* MOD = (float*)((unsigned char*)p.out + OB_MOD);
    f32x2* CS = (f32x2*)((unsigned char*)p.out + OB_CS);
    for (int idx = blockIdx.x * 512 + tid; idx < 4096; idx += gridDim.x * 512) {
        const int pos = idx >> 6, pp = idx & 63;
        const float inv = powf(10000.0f, -(float)(2 * pp) / 128.0f);
        const float angf = (float)pos * inv;
        double a = (double)angf;
        const double k = rint(a * 0.6366197723675814);
        const double rr = (a - k * 1.5707963267948966) - k * 6.123233995736766e-17;
        const int qd = ((int)k) & 3;
        const double r2 = rr * rr;
        double sn = rr * (1.0 + r2 * (-1.0 / 6 + r2 * (1.0 / 120 + r2 * (-1.0 / 5040 + r2 * (1.0 / 362880 + r2 * (-1.0 / 39916800 + r2 * (1.0 / 6227020800.0)))))));
        double cn = 1.0 + r2 * (-0.5 + r2 * (1.0 / 24 + r2 * (-1.0 / 720 + r2 * (1.0 / 40320 + r2 * (-1.0 / 3628800 + r2 * (1.0 / 479001600.0 + r2 * (-1.0 / 87178291200.0)))))));
        double cs_, sn_;
        if (qd == 0) { cs_ = cn; sn_ = sn; } else if (qd == 1) { cs_ = -sn; sn_ = cn; } else if (qd == 2) { cs_ = -cn; sn_ = -sn; } else { cs_ = sn; sn_ = -cn; }
        CS[idx] = (f32x2){(float)cs_, (float)sn_};
    }
    for (int it = blockIdx.x; it < 4 * 96; it += gridDim.x) {
        const int layer = it / 96, cb = it % 96;
        for (int idx = tid; idx < 33 * 1024; idx += 512) { const int r = idx >> 10, k = idx & 1023; const float v = r < 32 ? p.c[r * 1024 + k] : p.c_ctx[k]; lds[idx] = silu_f(v); }
        __syncthreads();
        const float* wp = p.ada_w + (size_t)layer * 1024 * 6144 + cb * 64 + lane;
        float acc[33];
#pragma unroll
        for (int r = 0; r < 33; ++r) acc[r] = 0.f;
        for (int k = wid * 128; k < wid * 128 + 128; k += 4) {
            const float w0 = wp[(size_t)k * 6144], w1 = wp[(size_t)(k + 1) * 6144], w2 = wp[(size_t)(k + 2) * 6144], w3 = wp[(size_t)(k + 3) * 6144];
#pragma unroll
            for (int r = 0; r < 33; ++r) { const f32x4 s4 = *(const f32x4*)(lds + r * 1024 + k); acc[r] += s4[0] * w0 + s4[1] * w1 + s4[2] * w2 + s4[3] * w3; }
        }
        __syncthreads();
#pragma unroll
        for (int r = 0; r < 33; ++r) lds[(wid * 33 + r) * 64 + lane] = acc[r];
        __syncthreads();
        for (int idx = tid; idx < 33 * 64; idx += 512) { const int r = idx >> 6, l = idx & 63; float sm = 0.f;
#pragma unroll
            for (int w = 0; w < 8; ++w) sm += lds[(w * 33 + r) * 64 + l];
            MOD[((size_t)layer * 33 + r) * 6144 + cb * 64 + l] = sm + p.ada_b[layer * 6144 + cb * 64 + l]; }
        __syncthreads();
    }
    for (int it = blockIdx.x; it < 6336; it += gridDim.x) {
        int i = it;
        if (i < 1536) { const int j = i / 768, r = i % 768, nt = r / 8, kt = r % 8;
            conv_tile(p.ret_w_in + (size_t)j * 1024 * 6144, 6144, Wb + W_RETIN + (size_t)j * 6144 * 1024, 1024, nt * 64, kt * 128, 1, lds); continue; }
        i -= 1536;
        if (i < 512) { const int j = i / 256, r = i % 256, nt = r / 16, kt = r % 16;
            conv_tile(p.ret_w_out + (size_t)j * 2048 * 1024, 1024, Wb + W_RETOUT + (size_t)j * 1024 * 2048, 2048, nt * 64, kt * 128, 0, lds); continue; }
        i -= 512;
        if (i < 64) { const int jg = i / 8, r = i % 8, nt = r / 2, kt = r % 2;
            conv_tile(p.pool_w + (size_t)jg * 65536, 256, Wb + W_POOL + (size_t)jg * 65536, 256, nt * 64, kt * 128, 0, lds); continue; }
        i -= 64;
        if (i < 2816) { const int l = i / 704, r = i % 704, nt = r / 8, kt = r % 8;
            conv_tile(p.ffn_w_in + (size_t)l * 1024 * 5632, 5632, Wb + W_FFNIN + (size_t)l * 5632 * 1024, 1024, nt * 64, kt * 128, 2, lds); continue; }
        i -= 2816;
        { const int l = i / 352, r = i % 352, nt = r / 22, kt = r % 22;
            conv_tile(p.ffn_w_out + (size_t)l * HID * 1024, 1024, Wb + W_FFNOUT + (size_t)l * 1024 * HID, HID, nt * 64, kt * 128, 0, lds); }
    }
}

constexpr int QS_LD = 264, KS_LD = 272, P_LD = 80, QP_LD = 272;
template <int ST>
__device__ __forceinline__ void kt_issue(unsigned addr, u32x2 (&o)[8]) {
    constexpr int RB = KS_LD * 2;
    asm volatile(
        "ds_read_b64_tr_b16 %0, %8 offset:%9\n\t"
        "ds_read_b64_tr_b16 %1, %8 offset:%10\n\t"
        "ds_read_b64_tr_b16 %2, %8 offset:%11\n\t"
        "ds_read_b64_tr_b16 %3, %8 offset:%12\n\t"
        "ds_read_b64_tr_b16 %4, %8 offset:%13\n\t"
        "ds_read_b64_tr_b16 %5, %8 offset:%14\n\t"
        "ds_read_b64_tr_b16 %6, %8 offset:%15\n\t"
        "ds_read_b64_tr_b16 %7, %8 offset:%16"
        : "=&v"(o[0]), "=&v"(o[1]), "=&v"(o[2]), "=&v"(o[3]), "=&v"(o[4]), "=&v"(o[5]), "=&v"(o[6]), "=&v"(o[7])
        : "v"(addr),
          "n"((0 * 32 + 0) * RB + 32 * (2 * ST)), "n"((0 * 32 + 4) * RB + 32 * (2 * ST)),
          "n"((1 * 32 + 0) * RB + 32 * (2 * ST)), "n"((1 * 32 + 4) * RB + 32 * (2 * ST)),
          "n"((0 * 32 + 0) * RB + 32 * (2 * ST + 1)), "n"((0 * 32 + 4) * RB + 32 * (2 * ST + 1)),
          "n"((1 * 32 + 0) * RB + 32 * (2 * ST + 1)), "n"((1 * 32 + 4) * RB + 32 * (2 * ST + 1))
        : "memory");
}
template <int N>
__device__ __forceinline__ void kt_wait(u32x2 (&o)[8]) {
    asm volatile("s_waitcnt lgkmcnt(%8)" : "+v"(o[0]), "+v"(o[1]), "+v"(o[2]), "+v"(o[3]), "+v"(o[4]), "+v"(o[5]), "+v"(o[6]), "+v"(o[7]) : "n"(N) : "memory");
}
constexpr int VS_LD = 136;
__device__ __forceinline__ void vt_issue(unsigned addr, u32x2 (&o)[4]) {
    constexpr int RB = VS_LD * 2;
    asm volatile(
        "ds_read_b64_tr_b16 %0, %4 offset:%5\n\t"
        "ds_read_b64_tr_b16 %1, %4 offset:%6\n\t"
        "ds_read_b64_tr_b16 %2, %4 offset:%7\n\t"
        "ds_read_b64_tr_b16 %3, %4 offset:%8"
        : "=&v"(o[0]), "=&v"(o[1]), "=&v"(o[2]), "=&v"(o[3])
        : "v"(addr), "n"(0 * RB), "n"(4 * RB), "n"(32 * RB), "n"(36 * RB)
        : "memory");
}
__device__ __forceinline__ void vt_wait(u32x2 (&o)[4]) {
    asm volatile("s_waitcnt lgkmcnt(0)" : "+v"(o[0]), "+v"(o[1]), "+v"(o[2]), "+v"(o[3]) : : "memory");
}
__device__ __forceinline__ bf16x8 kt_frag(const u32x2& a, const u32x2& b) { return __builtin_bit_cast(bf16x8, (u32x4){a.x, a.y, b.x, b.y}); }
template <int ST, bool LAST>
__device__ __forceinline__ void kt_step(unsigned addr, u32x2 (&cur)[8], u32x2 (&nxt)[8], f32x4 (&S)[16], const bf16x8 (&Vs)[2], float Gc) {
    if constexpr (!LAST) kt_issue<ST + 1>(addr, nxt);
    kt_wait<LAST ? 0 : 8>(cur);
    constexpr int m0 = 2 * ST, m1 = 2 * ST + 1;
    S[m0] = S[m0] * Gc; S[m1] = S[m1] * Gc;
    S[m0] = __builtin_amdgcn_mfma_f32_16x16x32_bf16(kt_frag(cur[0], cur[1]), Vs[0], S[m0], 0, 0, 0);
    S[m1] = __builtin_amdgcn_mfma_f32_16x16x32_bf16(kt_frag(cur[4], cur[5]), Vs[0], S[m1], 0, 0, 0);
    S[m0] = __builtin_amdgcn_mfma_f32_16x16x32_bf16(kt_frag(cur[2], cur[3]), Vs[1], S[m0], 0, 0, 0);
    S[m1] = __builtin_amdgcn_mfma_f32_16x16x32_bf16(kt_frag(cur[6], cur[7]), Vs[1], S[m1], 0, 0, 0);
}
template <bool WITH_B>
__device__ __forceinline__ void scan_bc(const bf16_t* Ps, const bf16_t* Qp, int r, int g, const bf16x8 (&Vf)[2], const f32x4 (&S)[16], f32x4 (&o1)[4], f32x4 (&o2)[4]) {
    constexpr int S0 = WITH_B ? 0 : 2;
    u32x4 fb[2][4];
    const bf16_t* pp = Ps + r * P_LD + 8 * g;
    const bf16_t* qp = Qp + r * QP_LD + 8 * g;
    if constexpr (WITH_B) {
#pragma unroll
        for (int nt = 0; nt < 4; ++nt) fb[0][nt] = *(const u32x4*)(pp + 16 * nt * P_LD);
    } else {
#pragma unroll
        for (int nt = 0; nt < 4; ++nt) fb[0][nt] = *(const u32x4*)(qp + 16 * nt * QP_LD);
    }
#pragma unroll
    for (int st = S0; st < 10; ++st) {
        const int nx = st + 1;
        if (nx < 2) {
#pragma unroll
            for (int nt = 0; nt < 4; ++nt) fb[nx & 1][nt] = *(const u32x4*)(pp + 16 * nt * P_LD + 32 * nx);
        } else if (nx < 10) {
#pragma unroll
            for (int nt = 0; nt < 4; ++nt) fb[nx & 1][nt] = *(const u32x4*)(qp + 16 * nt * QP_LD + 32 * (nx - 2));
        }
        if (st < 2) {
#pragma unroll
            for (int nt = 0; nt < 4; ++nt) o1[nt] = __builtin_amdgcn_mfma_f32_16x16x32_bf16(Vf[st], __builtin_bit_cast(bf16x8, fb[st & 1][nt]), o1[nt], 0, 0, 0);
        } else {
            const int T = st - 2;
            u32x4 aw; aw.x = cvt_pk_bf16(S[2 * T][0], S[2 * T][1]); aw.y = cvt_pk_bf16(S[2 * T][2], S[2 * T][3]); aw.z = cvt_pk_bf16(S[2 * T + 1][0], S[2 * T + 1][1]); aw.w = cvt_pk_bf16(S[2 * T + 1][2], S[2 * T + 1][3]);
            const bf16x8 a = __builtin_bit_cast(bf16x8, aw);
#pragma unroll
            for (int nt = 0; nt < 4; ++nt) o2[nt] = __builtin_amdgcn_mfma_f32_16x16x32_bf16(a, __builtin_bit_cast(bf16x8, fb[st & 1][nt]), o2[nt], 0, 0, 0);
        }
        __builtin_amdgcn_sched_barrier(0);
    }
}

__device__ void ret_phase(const Params& p, unsigned char* ldsb, int lj, int half) {
    const int tid0 = opaque_tid(), w = __builtin_amdgcn_readfirstlane(tid0 >> 6), lane0 = tid0 & 63, r0_ = lane0 & 15, g0_ = lane0 >> 4;
    bf16_t* Qs = (bf16_t*)ldsb;
    bf16_t* Ks = Qs + 64 * QS_LD;
    bf16_t* Ps = Ks + 64 * KS_LD;
    bf16_t* Vl = Ps + 64 * P_LD;
    bf16_t* Qp = Vl + 64 * VS_LD;
    const bf16_t* Qg = (const bf16_t*)(p.ws + WS_R1);
    const bf16_t* Kg = Qg + (size_t)TH * 1024;
    const bf16_t* Vg = Kg + (size_t)TH * 1024;
    bf16_t* Y = (bf16_t*)(p.ws + WS_Y);
    const int jb = w & 3, ih = w >> 2;
    for (int item = blockIdx.x; item < 256; item += gridDim.x) {
        const int xq = item & 7, yq = item >> 3, sl = yq & 3, bh = (yq >> 2) * 8 + xq, bl = bh >> 2, h = bh & 3;
        const int bglob = half * 16 + bl;
        const float l2gF = -fabsf(p.ret_log_decay[(lj * 2 + 0) * 4 + h]) * 1.4426950408889634f, l2gB = -fabsf(p.ret_log_decay[(lj * 2 + 1) * 4 + h]) * 1.4426950408889634f;
        for (int pass = 0; pass < 2; ++pass) {
            const int dir = 1 - pass;
            const float lg = -fabsf(p.ret_log_decay[(lj * 2 + dir) * 4 + h]);
            const float l2g = lg * 1.4426950408889634f;
            const float Gc = __builtin_amdgcn_exp2f(64.0f * l2g);
            float ge[8];
#pragma unroll
            for (int e = 0; e < 8; ++e) ge[e] = __builtin_amdgcn_exp2f((dir == 0 ? -(float)e : (float)e) * l2g);
            f32x4 S[16];
#pragma unroll
            for (int i = 0; i < 16; ++i) S[i] = (f32x4){0.f, 0.f, 0.f, 0.f};
            u32x4 sq[4], sk[4]; u32x4 sv[2]; u32x2 yold[4];
            auto spos = [&](int c) -> int { return dir == 0 ? 64 * c : (c < 4 ? 192 - 64 * c : 2496 - 64 * c); };
            auto lrow = [&](int s0) -> int { return s0 < 256 ? bl * 256 + s0 : 4096 + bl * 2048 + (s0 - 256); };
            auto grow = [&](int s0) -> int { return s0 < 256 ? bglob * 256 + s0 : TCTX + bglob * 2048 + (s0 - 256); };
            const unsigned vo_qk = (unsigned)(((tid0 >> 5) * 1024 + (tid0 & 31) * 8) * 2);
            const unsigned vo_v = (unsigned)(((tid0 >> 4) * 2048 + (tid0 & 15) * 8) * 2);
            const unsigned vo_y = (unsigned)((r0_ * 2048 + 4 * g0_) * 2);
            auto issueQ = [&](int c) { const char* bq = (const char*)(Qg + (size_t)lrow(spos(c)) * 1024 + h * 256);
#pragma unroll
                for (int k = 0; k < 4; ++k) sq[k] = *(const u32x4*)(bq + (size_t)k * 32768 + vo_qk); };
            auto issueK = [&](int c) { const char* bk = (const char*)(Kg + (size_t)lrow(spos(c)) * 1024 + h * 256);
#pragma unroll
                for (int k = 0; k < 4; ++k) sk[k] = *(const u32x4*)(bk + (size_t)k * 32768 + vo_qk); };
            auto issueVY = [&](int c) { const char* bv = (const char*)(Vg + (size_t)lrow(spos(c)) * 2048 + h * 512 + sl * 128);
#pragma unroll
                for (int k = 0; k < 2; ++k) sv[k] = *(const u32x4*)(bv + (size_t)k * 131072 + vo_v);
                if (pass == 1) { const char* by = (const char*)(Y + (size_t)grow(spos(c)) * 2048 + h * 512 + sl * 128 + 16 * w);
#pragma unroll
                    for (int nt = 0; nt < 4; ++nt) yold[nt] = *(const u32x2*)(by + (size_t)nt * 65536 + vo_y); } };
            issueQ(0); issueK(0); issueVY(0);
            for (int c = 0; c < 36; ++c) {
                const int s0 = spos(c);
                int tid = tid0, r = r0_, g = g0_; asm volatile("" : "+v"(tid), "+v"(r), "+v"(g));
                const int grow0 = grow(s0);
#pragma unroll
                for (int k = 0; k < 4; ++k) { const int ch = tid + 512 * k, ri = ch >> 5, cc = ch & 31;
                    if (pass == 0) *(u32x4*)(Qs + ri * QS_LD + cc * 8) = sq[k];
                    bf16_t* qd_ = Qp + ri * QP_LD + 32 * (cc >> 2) + 16 * (cc & 1) + 4 * ((cc >> 1) & 1);
                    *(u32x2*)qd_ = (u32x2){sq[k].x, sq[k].y}; *(u32x2*)(qd_ + 8) = (u32x2){sq[k].z, sq[k].w};
                    *(u32x4*)(Ks + ri * KS_LD + cc * 8) = sk[k]; }
#pragma unroll
                for (int k = 0; k < 2; ++k) { const int ch = tid + 512 * k, ri = ch >> 4, cc = ch & 15; *(u32x4*)(Vl + ri * VS_LD + cc * 8) = sv[k]; }
                u32x2 yo[4];
#pragma unroll
                for (int nt = 0; nt < 4; ++nt) yo[nt] = yold[nt];
                __syncthreads();
                u32x2 vv[4];
                vt_issue((unsigned)(size_t)Vl + (unsigned)(((8 * g + (r >> 2)) * VS_LD + 16 * w + 4 * (r & 3)) * 2), vv);
                if (c + 1 < 36) issueQ(c + 1);
                vt_wait(vv);
                bf16x8 Vf[2], Vs[2];
#pragma unroll
                for (int t = 0; t < 2; ++t) {
                    const u32x4 vft = (u32x4){vv[2 * t].x, vv[2 * t].y, vv[2 * t + 1].x, vv[2 * t + 1].y};
                    Vf[t] = __builtin_bit_cast(bf16x8, vft);
                    const int j0 = 32 * t + 8 * g;
                    const float base = __builtin_amdgcn_exp2f((dir == 0 ? (float)(63 - j0) : (float)j0) * l2g);
                    const unsigned uu[4] = {vft.x, vft.y, vft.z, vft.w};
                    unsigned oo[4];
#pragma unroll
                    for (int e2 = 0; e2 < 4; ++e2) oo[e2] = cvt_pk_bf16(bf_lo(uu[e2]) * (base * ge[2 * e2]), bf_hi(uu[e2]) * (base * ge[2 * e2 + 1]));
                    Vs[t] = __builtin_bit_cast(bf16x8, (u32x4){oo[0], oo[1], oo[2], oo[3]});
                }
                const bool deadout = (lj == 1) && (s0 < 256);
                if (pass == 0 && !deadout) {
                    f32x4 sc[2] = {(f32x4){0.f, 0.f, 0.f, 0.f}, (f32x4){0.f, 0.f, 0.f, 0.f}};
                    const bf16_t* kp = Ks + (16 * jb + r) * KS_LD + 8 * g;
                    const bf16_t* qp0 = Qs + (32 * ih + r) * QS_LD + 8 * g;
                    bf16x8 ka[2], qb[2][2];
                    ka[0] = *(const bf16x8*)kp; qb[0][0] = *(const bf16x8*)qp0; qb[0][1] = *(const bf16x8*)(qp0 + 16 * QS_LD);
#pragma unroll
                    for (int t = 0; t < 8; ++t) {
                        if (t + 1 < 8) { ka[(t + 1) & 1] = *(const bf16x8*)(kp + 32 * (t + 1)); qb[(t + 1) & 1][0] = *(const bf16x8*)(qp0 + 32 * (t + 1)); qb[(t + 1) & 1][1] = *(const bf16x8*)(qp0 + 16 * QS_LD + 32 * (t + 1)); }
                        sc[0] = __builtin_amdgcn_mfma_f32_16x16x32_bf16(ka[t & 1], qb[t & 1][0], sc[0], 0, 0, 0);
                        sc[1] = __builtin_amdgcn_mfma_f32_16x16x32_bf16(ka[t & 1], qb[t & 1][1], sc[1], 0, 0, 0);
                        __builtin_amdgcn_sched_barrier(0);
                    }
#pragma unroll
                    for (int nt = 0; nt < 2; ++nt) { const int i = 32 * ih + 16 * nt + r; const int j0 = 16 * jb + 4 * g;
                        float pv[4];
#pragma unroll
                        for (int jj = 0; jj < 4; ++jj) { const int df = j0 + jj - i;
                            pv[jj] = sc[nt][jj] * __builtin_amdgcn_exp2f(df > 0 ? (float)df * l2gB : (float)(-df) * l2gF); }
                        u32x2 o; o.x = cvt_pk_bf16(pv[0], pv[1]); o.y = cvt_pk_bf16(pv[2], pv[3]);
                        *(u32x2*)(Ps + i * P_LD + j0) = o; }
                }
                if (c + 1 < 36) issueK(c + 1);
                f32x4 o1[4], o2[4];
#pragma unroll
                for (int nt = 0; nt < 4; ++nt) { o1[nt] = (f32x4){0.f, 0.f, 0.f, 0.f}; o2[nt] = (f32x4){0.f, 0.f, 0.f, 0.f}; }
                if (!deadout) {
                    if (pass == 0) { __syncthreads(); scan_bc<true>(Ps, Qp, r, g, Vf, S, o1, o2); }
                    else if (c > 0) scan_bc<false>(Ps, Qp, r, g, Vf, S, o1, o2);
                }
                if (c + 1 < 36) issueVY(c + 1);
                if (c < 35) {
                    u32x2 fa0[8], fa1[8];
                    const unsigned kaddr = (unsigned)(size_t)Ks + (unsigned)(((8 * g + (r >> 2)) * KS_LD + 4 * (r & 3)) * 2);
                    kt_issue<0>(kaddr, fa0);
                    kt_step<0, false>(kaddr, fa0, fa1, S, Vs, Gc);
                    kt_step<1, false>(kaddr, fa1, fa0, S, Vs, Gc);
                    kt_step<2, false>(kaddr, fa0, fa1, S, Vs, Gc);
                    kt_step<3, false>(kaddr, fa1, fa0, S, Vs, Gc);
                    kt_step<4, false>(kaddr, fa0, fa1, S, Vs, Gc);
                    kt_step<5, false>(kaddr, fa1, fa0, S, Vs, Gc);
                    kt_step<6, false>(kaddr, fa0, fa1, S, Vs, Gc);
                    kt_step<7, true>(kaddr, fa1, fa0, S, Vs, Gc);
                }
                if (!deadout)
#pragma unroll
                for (int nt = 0; nt < 4; ++nt) { const int i = 16 * nt + r;
                    const float qd = __builtin_amdgcn_exp2f((dir == 0 ? (float)(i + 1) : (float)(64 - i)) * l2g);
                    f32x4 yv = o1[nt] + o2[nt] * qd;
                    bf16_t* yp = (bf16_t*)((char*)(Y + (size_t)grow0 * 2048 + h * 512 + sl * 128 + 16 * w) + (size_t)nt * 65536 + vo_y);
                    if (pass == 1) { yv[0] += bf_lo(yo[nt].x); yv[1] += bf_hi(yo[nt].x); yv[2] += bf_lo(yo[nt].y); yv[3] += bf_hi(yo[nt].y); }
                    u32x2 o; o.x = cvt_pk_bf16(yv[0], yv[1]); o.y = cvt_pk_bf16(yv[2], yv[3]);
                    *(u32x2*)yp = o; }
                __syncthreads();
            }
        }
    }
}

__device__ __forceinline__ void gbar(unsigned* ctr, unsigned& target) {
    asm volatile("s_waitcnt vmcnt(0) lgkmcnt(0)" ::: "memory");
    __syncthreads();
    target += gridDim.x;
    if (threadIdx.x == 0) {
        __builtin_amdgcn_fence(__ATOMIC_RELEASE, "agent");
        asm volatile("s_waitcnt vmcnt(0)" ::: "memory");
        __hip_atomic_fetch_add(ctr, 1u, __ATOMIC_RELAXED, __HIP_MEMORY_SCOPE_AGENT);
        while (__hip_atomic_load(ctr, __ATOMIC_RELAXED, __HIP_MEMORY_SCOPE_AGENT) < target) __builtin_amdgcn_s_sleep(2);
        __builtin_amdgcn_fence(__ATOMIC_ACQUIRE, "agent");
        asm volatile("s_waitcnt vmcnt(0)" ::: "memory");
    }
    __syncthreads();
}

__global__ void __launch_bounds__(512, 2) mega(Params p) {
    extern __shared__ __attribute__((aligned(16))) unsigned char shm[];
    cg::grid_group grid = cg::this_grid();
    LAS unsigned char* lds = (LAS unsigned char*)shm;
    float* X = (float*)(p.ws + WS_X);
    unsigned char* R1 = p.ws + WS_R1;
    bf16_t* Y = (bf16_t*)(p.ws + WS_Y);
    bf16_t* H = (bf16_t*)((unsigned char*)p.out + OB_H);
    const bf16_t* Wb = (const bf16_t*)((unsigned char*)p.out + OB_W);
    const float* MOD = (const float*)((unsigned char*)p.out + OB_MOD);
    const f32x2* CS = (const f32x2*)((unsigned char*)p.out + OB_CS);
    const TileMap idm = {1 << 30, 0, 0};
    unsigned* bar = (unsigned*)(p.ws + WS_BAR); unsigned btarget = 0;

    phase0(p, (float*)shm);
    grid.sync();

    for (int layer = 0; layer < 4; ++layer) {
        const bool last = layer == 3;
        const bool use_ret = (layer & 1) == 0;
        const int lj = layer >> 1;
        const float* modl = MOD + (size_t)layer * 33 * 6144;
        const int r0 = last ? TCTX : 0;
        const TileMap rowmap = last ? TileMap{0, 0, 32} : idm;
        const int Mrows = last ? (TT - TCTX) : TT;
        const bool latpost = layer >= 2;
        const int r0p = latpost ? TCTX : 0;
        const TileMap rowmapp = latpost ? TileMap{0, 0, 32} : idm;
        const int Mrowsp = latpost ? (TT - TCTX) : TT;

        const float* Xc = layer == 0 ? p.ctx : X; const float* Xl = layer == 0 ? p.x - (size_t)TCTX * 1024 : X;
        norm_phase(Xc, Xl, H, p.norm1_w + layer * 1024, modl, 0, 1, r0, TT);
        gbar(bar, btarget);

        if (use_ret) {
            const bf16_t* Win = Wb + W_RETIN + (size_t)lj * 6144 * 1024;
            bf16_t* Qg = (bf16_t*)R1; bf16_t* Kg = Qg + (size_t)TH * 1024; bf16_t* VTg = Kg + (size_t)TH * 1024;
            for (int half = 0; half < 2; ++half) {
                const TileMap hm = {16, 16 * half, 32 + 128 * half};
                { Gemm g = {H, Win + (size_t)2048 * 1024, 1024, 1024, TH, 4096, 1024, hm, idm, 0};
                  EpiQK E = {Qg, Kg, VTg, CS, hm};
                  pg8::gemm_phase(lds, g, E); }
                gbar(bar, btarget);
                ret_phase(p, shm, lj, half);
                gbar(bar, btarget);
            }
            stats_phase(Y, (f32x2*)(p.ws + WS_ST), r0p);
            gbar(bar, btarget);
            { Gemm g = {H, Win, 1024, 1024, Mrowsp, 2048, 1024, rowmapp, idm, 0};
              EpiSiluGN E = {(bf16_t*)R1, rowmapp, Y, (const f32x2*)(p.ws + WS_ST), p.ret_gn_w + lj * 2048};
              pg8::gemm_phase(lds, g, E); }
            gbar(bar, btarget);
            { Gemm g = {(const bf16_t*)R1, Wb + W_RETOUT + (size_t)lj * 1024 * 2048, 2048, 2048, Mrowsp, 1024, 2048, rowmapp, idm, 0};
              EpiRes E = {X, Xc, Xl, modl, 2, nullptr, rowmapp};
              pg8::gemm_phase(lds, g, E); }
            gbar(bar, btarget);
        } else {
            pool_phase(H, (bf16_t*)R1, r0, TT);
            gbar(bar, btarget);
            { Gemm g = {(const bf16_t*)R1, Wb + W_POOL + (size_t)lj * 262144, 1024, 256, Mrows, 1024, 256, rowmap, idm, 512};
              EpiRes E = {X, X, X, modl, 2, p.pool_scale + lj * 1024, rowmap};
              pg8::gemm_phase(lds, g, E); }
            gbar(bar, btarget);
        }

        norm_phase(X, X, H, p.norm2_w + layer * 1024, modl, 3, 4, r0p, TT);
        gbar(bar, btarget);
        { Gemm g = {H, Wb + W_FFNIN + (size_t)layer * 5632 * 1024, 1024, 1024, Mrowsp, 5632, 1024, rowmapp, idm, 0};
          EpiSwiglu E = {(bf16_t*)R1, rowmapp};
          pg8::gemm_phase(lds, g, E); }
        gbar(bar, btarget);
        { Gemm g = {(const bf16_t*)R1, Wb + W_FFNOUT + (size_t)layer * 1024 * HID, HID, HID, Mrowsp, 1024, HID, rowmapp, idm, 0};
          EpiRes E = {X, X, X, modl, 5, nullptr, rowmapp};
          pg8::gemm_phase(lds, g, E); }
        gbar(bar, btarget);
    }
    final_norm_phase(X, p.out, p.final_norm_w);
}

extern "C" void kernel_launch(void* const* d_in, const int* in_sizes, int n_in, void* d_out, int out_size, void* d_ws, size_t ws_size, hipStream_t stream) {
    static int grid_blocks = 0;
    if (!grid_blocks) {
        if (ws_size < WS_END || n_in < 17) { fprintf(stderr, "kernel_launch: workspace too small (%zu < %zu) or n_in %d\n", ws_size, (size_t)WS_END, n_in); grid_blocks = -1; return; }
        int dev = 0, cus = 0, per_cu = 0;
        hipGetDevice(&dev);
        hipDeviceGetAttribute(&cus, hipDeviceAttributeMultiprocessorCount, dev);
        if (hipFuncSetAttribute((const void*)mega, hipFuncAttributeMaxDynamicSharedMemorySize, LDS_BYTES) != hipSuccess) { fprintf(stderr, "kernel_launch: hipFuncSetAttribute failed\n"); grid_blocks = -1; return; }
        hipOccupancyMaxActiveBlocksPerMultiprocessor(&per_cu, (const void*)mega, 512, LDS_BYTES);
        if (per_cu < 1) { fprintf(stderr, "kernel_launch: occupancy query returned %d\n", per_cu); per_cu = 1; }
        grid_blocks = cus * per_cu;
    }
    if (grid_blocks < 0) return;
    Params p{};
    p.x = (const float*)d_in[0]; p.c = (const float*)d_in[1]; p.ctx = (const float*)d_in[2]; p.c_ctx = (const float*)d_in[3];
    p.ada_w = (const float*)d_in[4]; p.ada_b = (const float*)d_in[5]; p.norm1_w = (const float*)d_in[6]; p.norm2_w = (const float*)d_in[7];
    p.ret_w_in = (const float*)d_in[8]; p.ret_log_decay = (const float*)d_in[9]; p.ret_gn_w = (const float*)d_in[10]; p.ret_w_out = (const float*)d_in[11];
    p.pool_w = (const float*)d_in[12]; p.pool_scale = (const float*)d_in[13]; p.ffn_w_in = (const float*)d_in[14]; p.ffn_w_out = (const float*)d_in[15];
    p.final_norm_w = (const float*)d_in[16];
    p.out = (float*)d_out; p.ws = (unsigned char*)d_ws;
    if (hipMemsetAsync((unsigned char*)d_ws + WS_BAR, 0, 256, stream) != hipSuccess) { fprintf(stderr, "kernel_launch: memset failed\n"); return; }
    void* args[] = {&p};
    hipError_t e = hipLaunchCooperativeKernel((const void*)mega, dim3(grid_blocks), dim3(512), args, LDS_BYTES, stream);
    if (e != hipSuccess) fprintf(stderr, "cooperative launch failed: %s (grid %d)\n", hipGetErrorString(e), grid_blocks);
}
```

```cpp
#include <hip/hip_runtime.h>
#include <hip/hip_cooperative_groups.h>
#include <cstdio>
namespace cg = cooperative_groups;

#define LAS __attribute__((address_space(3)))
typedef unsigned short bf16_t;
typedef short bf16x8 __attribute__((ext_vector_type(8)));
typedef float f32x4 __attribute__((ext_vector_type(4)));
typedef float f32x2 __attribute__((ext_vector_type(2)));
typedef unsigned u32x4 __attribute__((ext_vector_type(4)));
typedef unsigned u32x2 __attribute__((ext_vector_type(2)));

constexpr int DM = 1024, NB = 32, SEQ = 2048, CTXL = 256, HID = 2816;
constexpr int TCTX = NB * CTXL;
constexpr int TT = TCTX + NB * SEQ;
constexpr int TH = TT / 2;
constexpr int LDS_BYTES = 135168;

constexpr size_t WS_X = 0;
constexpr size_t WS_R1 = 301989888ull;
constexpr size_t WS_Y = WS_R1 + 377487360ull;
constexpr size_t WS_BAR = WS_Y + 301989888ull;
constexpr size_t WS_ST = WS_BAR + 256;
constexpr size_t WS_END = WS_ST + 2359296ull;
constexpr size_t OB_H = 0;
constexpr size_t OB_W = 150994944ull;
constexpr size_t OB_MOD = 254803968ull;
constexpr size_t OB_CS = 258048000ull;
constexpr size_t W_RETIN = 0, W_RETOUT = 12582912ull, W_POOL = 16777216ull, W_FFNIN = 17301504ull, W_FFNOUT = 40370176ull;

struct Params {
    const float *x, *c, *ctx, *c_ctx, *ada_w, *ada_b, *norm1_w, *norm2_w, *ret_w_in, *ret_log_decay, *ret_gn_w, *ret_w_out, *pool_w, *pool_scale, *ffn_w_in, *ffn_w_out, *final_norm_w;
    float* out; unsigned char* ws;
};

__device__ __forceinline__ unsigned cvt_pk_bf16(float lo, float hi) { unsigned r; asm("v_cvt_pk_bf16_f32 %0, %1, %2" : "=v"(r) : "v"(lo), "v"(hi)); return r; }
__device__ __forceinline__ float bf_lo(unsigned u) { return __uint_as_float(u << 16); }
__device__ __forceinline__ float bf_hi(unsigned u) { return __uint_as_float(u & 0xffff0000u); }
__device__ __forceinline__ int opaque_tid() { int t = threadIdx.x; asm volatile("" : "+v"(t)); return t; }
__device__ __forceinline__ float silu_f(float v) { return v * __builtin_amdgcn_rcpf(1.0f + __expf(-v)); }
__device__ __forceinline__ f32x4 silu4(f32x4 v) {
    f32x4 e, r;
#pragma unroll
    for (int j = 0; j < 4; ++j) e[j] = __builtin_amdgcn_exp2f(v[j] * -1.4426950408889634f);
#pragma unroll
    for (int j = 0; j < 4; ++j) r[j] = __builtin_amdgcn_rcpf(1.0f + e[j]);
    return v * r;
}

namespace pg8 {
constexpr int BM = 256, BK = 64, HALF = 128, HTB = HALF * BK * 2, STAGE_BYTES = 8 * HTB, NXCD = 8, WGM = 4;
__host__ __device__ __forceinline__ int lds_byte(int r, int c) { const int st = (r >> 4) * 2 + (c >> 5), rr = r & 15, cc = c & 31, ob = rr * 64 + cc * 2; return st * 1024 + (ob ^ (((ob >> 9) & 1) << 5)); }
__host__ __device__ __forceinline__ void stage_rc(int b, int& R, int& C) { const int st = b / 1024, sb = b % 1024, swz = sb ^ (((sb >> 9) & 1) << 5); R = (st >> 1) * 16 + swz / 64; C = (st & 1) * 32 + (swz % 64) / 2; }
__host__ __device__ __forceinline__ int perm32(int rho) { const int n = rho >> 4, i = rho & 15; return 8 * (i >> 2) + 4 * n + (i & 3); }

struct Unit { int pm, pn; };
struct TileMap { int nctx, ctx0, lat0; __device__ __forceinline__ int src(int t) const { return t < nctx ? ctx0 + t : lat0 + (t - nctx); } };
struct Gemm { const bf16_t* A; const bf16_t* Bt; int lda, ldb, M, N, K; TileMap mapA, mapB; int a_pn_step; };

struct StaticOrder {
    int nM, nN, nwg, G, c;
    __device__ void init(int M, int N, int G_, int c_) { nM = M / BM; nN = N / BM; nwg = nM * nN; G = G_; c = c_; }
    __device__ bool next(int i, Unit& u) const {
        const long L = (long)i * G + c; if (L >= nwg) return false;
        int wgid = (int)L; { const int q = nwg / NXCD, r = nwg % NXCD, xcd = wgid % NXCD, off = wgid / NXCD; wgid = (xcd < r ? xcd * (q + 1) : r * (q + 1) + (xcd - r) * q) + off; }
        const int nig = WGM * nN, gid = wgid / nig, fm = gid * WGM, gsz = (nM - fm) < WGM ? (nM - fm) : WGM;
        u.pm = fm + ((wgid % nig) % gsz); u.pn = (wgid % nig) / gsz; return true;
    }
};

template <class Epi>
__device__ __forceinline__ void gemm_phase(LAS unsigned char* lds, const Gemm g, const Epi& E) {
    const int tid = opaque_tid(), wid = __builtin_amdgcn_readfirstlane(tid >> 6), lane = tid & 63, wr = wid >> 2, wc = wid & 3, fr = lane & 15, fq = lane >> 4;
    const int K = g.K, nt = K / BK;
    StaticOrder S; S.init(g.M, g.N, (int)gridDim.x, (int)blockIdx.x);
    unsigned voffA[2], voffB[2];
#pragma unroll
    for (int i = 0; i < 2; ++i) { int R, C; stage_rc(tid * 16 + i * 8192, R, C); const int Rb = Epi::PERM ? ((R & ~31) + perm32(R & 31)) : R;
        voffA[i] = (unsigned)(R * g.lda + C) * 2u; voffB[i] = (unsigned)(Rb * g.ldb + C) * 2u; }
    const size_t kstep = (size_t)(BK * 2);
    const size_t hstepA = (size_t)HALF * g.lda * 2, hstepB = (size_t)HALF * g.ldb * 2;
    const size_t tstepA = 2 * hstepA, tstepB = 2 * hstepB;
    const unsigned ldsw = (unsigned)wid * 1024u;
    const int aoff = lds_byte(wr * 64 + fr, fq * 8), boff = lds_byte(wc * 32 + fr, fq * 8);
#define PG8_SA(b, h) (((b) * 2 + (h)) * HTB)
#define PG8_SB(b, h) ((4 + (b) * 2 + (h)) * HTB)
#define PG8_STAGE(bufoff, gbase, voff) do { _Pragma("unroll") for (int _i = 0; _i < 2; ++_i) \
        __builtin_amdgcn_global_load_lds((const unsigned*)((const char*)(gbase) + (voff)[_i]), (LAS unsigned*)(lds + (bufoff) + ldsw + _i * 8192), 16, 0, 0); } while (0)
#define PG8_LDA(dst, b, h) do { _Pragma("unroll") for (int m = 0; m < 4; ++m) _Pragma("unroll") for (int k = 0; k < 2; ++k) dst[m][k] = *(const LAS bf16x8*)(lds + PG8_SA(b, h) + aoff + m * 2048 + k * 1024); } while (0)
#define PG8_LDB(dst, b, h) do { _Pragma("unroll") for (int n = 0; n < 2; ++n) _Pragma("unroll") for (int k = 0; k < 2; ++k) dst[n][k] = *(const LAS bf16x8*)(lds + PG8_SB(b, h) + boff + n * 2048 + k * 1024); } while (0)
#define PG8_MMA(ai, bj, At, Bt) do { __builtin_amdgcn_s_setprio(1); _Pragma("unroll") for (int m = 0; m < 4; ++m) _Pragma("unroll") for (int n = 0; n < 2; ++n) _Pragma("unroll") for (int k = 0; k < 2; ++k) \
        acc[ai][bj][m][n] = __builtin_amdgcn_mfma_f32_16x16x32_bf16(Bt[n][k], At[m][k], acc[ai][bj][m][n], 0, 0, 0); __builtin_amdgcn_s_setprio(0); } while (0)
#define PG8_WAIT_V(n) asm volatile("s_waitcnt vmcnt(" #n ")" ::: "memory")
#define PG8_WAIT_L(n) asm volatile("s_waitcnt lgkmcnt(" #n ")" ::: "memory")
#define PG8_BAR __builtin_amdgcn_s_barrier()
#define PG8_SCHED __builtin_amdgcn_sched_barrier(0)
    Unit cur, nxt; int ui = 0;
    if (!S.next(0, cur)) return;
    f32x4 acc[2][2][4][2];
#pragma unroll
    for (int a = 0; a < 2; ++a)
#pragma unroll
        for (int b = 0; b < 2; ++b)
#pragma unroll
            for (int m = 0; m < 4; ++m)
#pragma unroll
                for (int n = 0; n < 2; ++n) acc[a][b][m][n] = (f32x4){0.f, 0.f, 0.f, 0.f};
    bf16x8 At[4][2], B0[2][2], B1[2][2];
    const char* cA = (const char*)g.A + (size_t)g.mapA.src(cur.pm) * tstepA + (size_t)cur.pn * g.a_pn_step;
    const char* cB = (const char*)g.Bt + (size_t)g.mapB.src(cur.pn) * tstepB;
    PG8_STAGE(PG8_SB(0, 0), cB, voffB); PG8_STAGE(PG8_SA(0, 0), cA, voffA); PG8_STAGE(PG8_SB(0, 1), cB + hstepB, voffB); PG8_STAGE(PG8_SA(0, 1), cA + hstepA, voffA);
    if (wr == 1) PG8_BAR;
    PG8_WAIT_V(4); PG8_BAR;
    PG8_STAGE(PG8_SB(1, 0), cB + kstep, voffB); PG8_STAGE(PG8_SA(1, 0), cA + kstep, voffA); PG8_STAGE(PG8_SB(1, 1), cB + hstepB + kstep, voffB);
    PG8_WAIT_V(6); PG8_BAR;
    for (;;) {
        const bool has_next = S.next(ui + 1, nxt);
        const char* nA = has_next ? (const char*)g.A + (size_t)g.mapA.src(nxt.pm) * tstepA + (size_t)nxt.pn * g.a_pn_step : cA;
        const char* nB = has_next ? (const char*)g.Bt + (size_t)g.mapB.src(nxt.pn) * tstepB : cB;
        for (int t = 0; t < nt; t += 2) {
            const bool last = (t == nt - 2);
            const char* a1 = cA + (size_t)(t + 1) * kstep;
            const char* a2 = last ? nA : cA + (size_t)(t + 2) * kstep; const char* b2 = last ? nB : cB + (size_t)(t + 2) * kstep;
            const char* a3 = a2 + kstep; const char* b3 = b2 + kstep;
            PG8_LDB(B0, 0, 0); PG8_SCHED; PG8_LDA(At, 0, 0); PG8_STAGE(PG8_SA(1, 1), a1 + hstepA, voffA);
            PG8_WAIT_L(8); PG8_BAR; PG8_WAIT_L(0); PG8_MMA(0, 0, At, B0); PG8_BAR; PG8_SCHED;
            PG8_LDB(B1, 0, 1); PG8_STAGE(PG8_SB(0, 0), b2, voffB);
            PG8_BAR; PG8_WAIT_L(0); PG8_MMA(0, 1, At, B1); PG8_BAR;
            PG8_LDA(At, 0, 1); PG8_STAGE(PG8_SA(0, 0), a2, voffA);
            PG8_BAR; PG8_WAIT_L(0); PG8_MMA(1, 0, At, B0); PG8_BAR; PG8_SCHED;
            PG8_STAGE(PG8_SB(0, 1), b2 + hstepB, voffB);
            PG8_WAIT_V(6); PG8_BAR; PG8_MMA(1, 1, At, B1); PG8_BAR;
            PG8_LDB(B0, 1, 0); PG8_SCHED; PG8_LDA(At, 1, 0); PG8_STAGE(PG8_SA(0, 1), a2 + hstepA, voffA);
            PG8_WAIT_L(8); PG8_BAR; PG8_WAIT_L(0); PG8_MMA(0, 0, At, B0); PG8_BAR; PG8_SCHED;
            PG8_LDB(B1, 1, 1); PG8_STAGE(PG8_SB(1, 0), b3, voffB);
            PG8_BAR; PG8_WAIT_L(0); PG8_MMA(0, 1, At, B1); PG8_BAR;
            PG8_LDA(At, 1, 1); PG8_STAGE(PG8_SA(1, 0), a3, voffA);
            PG8_BAR; PG8_WAIT_L(0); PG8_MMA(1, 0, At, B0); PG8_BAR; PG8_SCHED;
            PG8_STAGE(PG8_SB(1, 1), b3 + hstepB, voffB);
            PG8_WAIT_V(6); PG8_BAR; PG8_MMA(1, 1, At, B1); PG8_BAR;
        }
        E(acc, cur, wr, wc, fr, fq);
        if (!has_next) break;
#pragma unroll
        for (int a = 0; a < 2; ++a)
#pragma unroll
            for (int b = 0; b < 2; ++b)
#pragma unroll
                for (int m = 0; m < 4; ++m)
#pragma unroll
                    for (int n = 0; n < 2; ++n) acc[a][b][m][n] = (f32x4){0.f, 0.f, 0.f, 0.f};
        cur = nxt; cA = nA; cB = nB; ++ui;
    }
    PG8_WAIT_V(0);
    if (wr == 0) PG8_BAR;
    PG8_BAR;
#undef PG8_SA
#undef PG8_SB
#undef PG8_STAGE
#undef PG8_LDA
#undef PG8_LDB
#undef PG8_MMA
#undef PG8_WAIT_V
#undef PG8_WAIT_L
#undef PG8_BAR
#undef PG8_SCHED
}
}
using pg8::Unit; using pg8::TileMap; using pg8::Gemm;

typedef f32x4 AccT[2][2][4][2];

struct EpiRes {
    static constexpr bool PERM = false;
    float* X; const float* Xc; const float* Xl; const float* modl; int gi; const float* scale; TileMap mapA;
    __device__ __forceinline__ void operator()(const AccT& acc, const Unit& u, int wr, int wc, int fr, int fq) const {
        asm volatile("" : "+v"(fr), "+v"(fq));
        const int gpm = mapA.src(u.pm);
        const int mb = gpm < 32 ? 32 : (gpm - 32) >> 3;
        const int row0 = gpm * 256 + wr * 64 + fr, col0 = u.pn * 256 + wc * 32 + 4 * fq;
        const float* gp = modl + ((size_t)mb * 6 + gi) * 1024;
        f32x4 gv[2][2];
#pragma unroll
        for (int bj = 0; bj < 2; ++bj)
#pragma unroll
            for (int n = 0; n < 2; ++n) { gv[bj][n] = *(const f32x4*)(gp + col0 + bj * 128 + n * 16); if (scale) gv[bj][n] = gv[bj][n] * *(const f32x4*)(scale + col0 + bj * 128 + n * 16); }
        const float* sbase = (gpm < 32 ? Xc : Xl) + (size_t)row0 * 1024 + col0;
#pragma unroll
        for (int ai = 0; ai < 2; ++ai) {
            f32x4 xo[4][2][2];
#pragma unroll
            for (int m = 0; m < 4; ++m)
#pragma unroll
                for (int bj = 0; bj < 2; ++bj)
#pragma unroll
                    for (int n = 0; n < 2; ++n) xo[m][bj][n] = *(const f32x4*)(sbase + (size_t)(ai * 128 + m * 16) * 1024 + bj * 128 + n * 16);
            __builtin_amdgcn_sched_barrier(0);
#pragma unroll
            for (int m = 0; m < 4; ++m) { float* rowp = X + (size_t)(row0 + ai * 128 + m * 16) * 1024 + col0;
#pragma unroll
                for (int bj = 0; bj < 2; ++bj)
#pragma unroll
                    for (int n = 0; n < 2; ++n) *(f32x4*)(rowp + bj * 128 + n * 16) = xo[m][bj][n] + gv[bj][n] * acc[ai][bj][m][n]; }
            __builtin_amdgcn_sched_barrier(0);
        }
    }
};

struct EpiQK {
    static constexpr bool PERM = true;
    bf16_t* Q; bf16_t* Kk; bf16_t* Vv; const f32x2* cs; TileMap mapA;
    __device__ __forceinline__ void operator()(const AccT& acc, const Unit& u, int wr, int wc, int fr, int fq) const {
        asm volatile("" : "+v"(fr), "+v"(fq));
        const int gpm = mapA.src(u.pm);
        const bool isq = u.pn < 4, isv = u.pn >= 8;
        const bool lat = gpm >= 32 && !isv;
        bf16_t* base = isq ? Q : (isv ? Vv + (size_t)(u.pn - 8) * 256 : Kk);
        const int hh = isv ? 0 : (u.pn & 3);
        const int ldo = isv ? 2048 : 1024;
        const float osc = isq ? 0.0625f : 1.0f;
        const int p0 = 16 * wc + 4 * fq;
        f32x4 ctR[2][2], ctC[4][2];
        if (lat) {
#pragma unroll
            for (int ai = 0; ai < 2; ++ai) { const int pr = ((gpm - 32) * 4 + 2 * ai + wr) & 31;
                ctR[ai][0] = *(const f32x4*)(cs + pr * 64 + p0); ctR[ai][1] = *(const f32x4*)(cs + pr * 64 + p0 + 2); }
#pragma unroll
            for (int m = 0; m < 4; ++m) { const int pc = m * 16 + fr;
                ctC[m][0] = *(const f32x4*)(cs + pc * 64 + p0); ctC[m][1] = *(const f32x4*)(cs + pc * 64 + p0 + 2); }
        }
        __builtin_amdgcn_sched_barrier(0);
#pragma unroll
        for (int ai = 0; ai < 2; ++ai)
#pragma unroll
            for (int m = 0; m < 4; ++m) {
                const int rl = ai * 128 + wr * 64 + m * 16 + fr;
                bf16_t* rowp = base + (size_t)(u.pm * 256 + rl) * ldo + hh * 256 + wc * 32 + 8 * fq;
#pragma unroll
                for (int bj = 0; bj < 2; ++bj) {
                    f32x4 v0 = acc[ai][bj][m][0], v1 = acc[ai][bj][m][1];
                    if (lat) {
                        const f32x4 c01 = bj ? ctC[m][0] : ctR[ai][0], c23 = bj ? ctC[m][1] : ctR[ai][1];
                        f32x4 r0, r1;
                        r0[0] = v0[0] * c01[0] - v0[1] * c01[1]; r0[1] = v0[0] * c01[1] + v0[1] * c01[0];
                        r0[2] = v0[2] * c01[2] - v0[3] * c01[3]; r0[3] = v0[2] * c01[3] + v0[3] * c01[2];
                        r1[0] = v1[0] * c23[0] - v1[1] * c23[1]; r1[1] = v1[0] * c23[1] + v1[1] * c23[0];
                        r1[2] = v1[2] * c23[2] - v1[3] * c23[3]; r1[3] = v1[2] * c23[3] + v1[3] * c23[2];
                        v0 = r0; v1 = r1;
                    }
                    v0 = v0 * osc; v1 = v1 * osc;
                    u32x4 w; w.x = cvt_pk_bf16(v0[0], v0[1]); w.y = cvt_pk_bf16(v0[2], v0[3]); w.z = cvt_pk_bf16(v1[0], v1[1]); w.w = cvt_pk_bf16(v1[2], v1[3]);
                    *(u32x4*)(rowp + bj * 128) = w;
                }
            }
    }
};

struct EpiSiluGN {
    static constexpr bool PERM = true;
    bf16_t* A2; TileMap mapA; const bf16_t* Y; const f32x2* ST; const float* gnw;
    __device__ __forceinline__ void operator()(const AccT& acc, const Unit& u, int wr, int wc, int fr, int fq) const {
        asm volatile("" : "+v"(fr), "+v"(fq));
        const int row0 = mapA.src(u.pm) * 256 + wr * 64 + fr, col0 = u.pn * 256 + wc * 32 + 8 * fq;
        const int hd = u.pn >> 1;
        f32x4 gw[2][2]; f32x2 st[2][4];
#pragma unroll
        for (int bj = 0; bj < 2; ++bj) { gw[bj][0] = *(const f32x4*)(gnw + col0 + bj * 128); gw[bj][1] = *(const f32x4*)(gnw + col0 + bj * 128 + 4); }
#pragma unroll
        for (int ai = 0; ai < 2; ++ai)
#pragma unroll
            for (int m = 0; m < 4; ++m) st[ai][m] = ST[(size_t)(row0 + ai * 128 + m * 16) * 4 + hd];
#pragma unroll
        for (int ai = 0; ai < 2; ++ai) {
            u32x4 yv[4][2];
#pragma unroll
            for (int m = 0; m < 4; ++m)
#pragma unroll
                for (int bj = 0; bj < 2; ++bj) yv[m][bj] = *(const u32x4*)(Y + (size_t)(row0 + ai * 128 + m * 16) * 2048 + col0 + bj * 128);
            __builtin_amdgcn_sched_barrier(0);
#pragma unroll
            for (int m = 0; m < 4; ++m) { bf16_t* rowp = A2 + (size_t)(row0 + ai * 128 + m * 16) * 2048 + col0;
                const float mu = st[ai][m][0], rs = st[ai][m][1];
#pragma unroll
                for (int bj = 0; bj < 2; ++bj) { const f32x4 v0 = acc[ai][bj][m][0], v1 = acc[ai][bj][m][1]; const u32x4 yw = yv[m][bj];
                    const f32x4 y0 = (f32x4){bf_lo(yw.x), bf_hi(yw.x), bf_lo(yw.y), bf_hi(yw.y)}, y1 = (f32x4){bf_lo(yw.z), bf_hi(yw.z), bf_lo(yw.w), bf_hi(yw.w)};
                    const f32x4 n0 = (y0 - mu) * rs * gw[bj][0], n1 = (y1 - mu) * rs * gw[bj][1];
                    const f32x4 s0 = silu4(v0) * n0, s1 = silu4(v1) * n1;
                    u32x4 w; w.x = cvt_pk_bf16(s0[0], s0[1]); w.y = cvt_pk_bf16(s0[2], s0[3]); w.z = cvt_pk_bf16(s1[0], s1[1]); w.w = cvt_pk_bf16(s1[2], s1[3]);
                    *(u32x4*)(rowp + bj * 128) = w; } }
            __builtin_amdgcn_sched_barrier(0);
        }
    }
};

struct EpiSwiglu {
    static constexpr bool PERM = true;
    bf16_t* U; TileMap mapA;
    __device__ __forceinline__ void operator()(const AccT& acc, const Unit& u, int wr, int wc, int fr, int fq) const {
        asm volatile("" : "+v"(fr), "+v"(fq));
        const int gpm = mapA.src(u.pm);
        const int row0 = gpm * 256 + wr * 64 + fr, col0 = u.pn * 128 + wc * 32 + 8 * fq;
#pragma unroll
        for (int ai = 0; ai < 2; ++ai)
#pragma unroll
            for (int m = 0; m < 4; ++m) { bf16_t* rowp = U + (size_t)(row0 + ai * 128 + m * 16) * HID + col0;
                const f32x4 s0 = silu4(acc[ai][0][m][0]) * acc[ai][1][m][0], s1 = silu4(acc[ai][0][m][1]) * acc[ai][1][m][1];
                u32x4 w; w.x = cvt_pk_bf16(s0[0], s0[1]); w.y = cvt_pk_bf16(s0[2], s0[3]); w.z = cvt_pk_bf16(s1[0], s1[1]); w.w = cvt_pk_bf16(s1[2], s1[3]);
                *(u32x4*)rowp = w; }
    }
};

__device__ void norm_phase(const float* Xc, const float* Xl, bf16_t* H, const float* nw, const float* modl, int shi, int sci, int r0, int r1) {
    const int tid_ = opaque_tid(); const int wid = tid_ >> 6, lane = tid_ & 63;
    for (int row = r0 + (blockIdx.x * 8 + wid) * 4; row < r1; row += gridDim.x * 32) {
        const float* xp = (row < TCTX ? Xc : Xl) + (size_t)row * 1024 + lane * 4;
        f32x4 v[4][4]; float ss[4];
#pragma unroll
        for (int u = 0; u < 4; ++u)
#pragma unroll
            for (int q = 0; q < 4; ++q) v[u][q] = *(const f32x4*)(xp + u * 1024 + q * 256);
#pragma unroll
        for (int u = 0; u < 4; ++u) { float a = 0.f;
#pragma unroll
            for (int q = 0; q < 4; ++q) a += v[u][q][0] * v[u][q][0] + v[u][q][1] * v[u][q][1] + v[u][q][2] * v[u][q][2] + v[u][q][3] * v[u][q][3];
            ss[u] = a; }
#pragma unroll
        for (int o = 32; o >= 1; o >>= 1)
#pragma unroll
            for (int u = 0; u < 4; ++u) ss[u] += __int_as_float(__builtin_amdgcn_ds_bpermute((lane ^ o) << 2, __float_as_int(ss[u])));
        const int mb = row < TCTX ? 32 : (row - TCTX) >> 11;
        const float* shp = modl + ((size_t)mb * 6 + shi) * 1024; const float* scp = modl + ((size_t)mb * 6 + sci) * 1024;
#pragma unroll
        for (int q = 0; q < 4; ++q) { const int c = q * 256 + lane * 4;
            const f32x4 w = *(const f32x4*)(nw + c), sh = *(const f32x4*)(shp + c), sc = *(const f32x4*)(scp + c);
            const f32x4 wm = w * (sc + 1.0f);
#pragma unroll
            for (int u = 0; u < 4; ++u) { const float rstd = rsqrtf(ss[u] * (1.0f / 1024.0f) + 1e-6f);
                const f32x4 h = (v[u][q] * rstd) * wm + sh;
                u32x2 o; o.x = cvt_pk_bf16(h[0], h[1]); o.y = cvt_pk_bf16(h[2], h[3]);
                *(u32x2*)(H + (size_t)(row + u) * 1024 + c) = o; } }
    }
}

__device__ void final_norm_phase(const float* X, float* out, const float* nw) {
    const int tid_ = opaque_tid(); const int wid = tid_ >> 6, lane = tid_ & 63;
    for (int row = TCTX + (blockIdx.x * 8 + wid) * 4; row < TT; row += gridDim.x * 32) {
        const float* xp = X + (size_t)row * 1024 + lane * 4;
        f32x4 v[4][4]; float ss[4];
#pragma unroll
        for (int u = 0; u < 4; ++u)
#pragma unroll
            for (int q = 0; q < 4; ++q) v[u][q] = *(const f32x4*)(xp + u * 1024 + q * 256);
#pragma unroll
        for (int u = 0; u < 4; ++u) { float a = 0.f;
#pragma unroll
            for (int q = 0; q < 4; ++q) a += v[u][q][0] * v[u][q][0] + v[u][q][1] * v[u][q][1] + v[u][q][2] * v[u][q][2] + v[u][q][3] * v[u][q][3];
            ss[u] = a; }
#pragma unroll
        for (int o = 32; o >= 1; o >>= 1)
#pragma unroll
            for (int u = 0; u < 4; ++u) ss[u] += __int_as_float(__builtin_amdgcn_ds_bpermute((lane ^ o) << 2, __float_as_int(ss[u])));
#pragma unroll
        for (int q = 0; q < 4; ++q) { const int c = q * 256 + lane * 4; const f32x4 w = *(const f32x4*)(nw + c);
#pragma unroll
            for (int u = 0; u < 4; ++u) { const float rstd = rsqrtf(ss[u] * (1.0f / 1024.0f) + 1e-6f);
                *(f32x4*)(out + (size_t)(row + u - TCTX) * 1024 + c) = (v[u][q] * rstd) * w; } }
    }
}

template <int HW>
__device__ __forceinline__ void pool_item(const bf16_t* H, bf16_t* Dd, int row, int c) {
    int sb, L, t;
    if (row < TCTX) { sb = row & ~255; L = 256; t = row & 255; } else { sb = TCTX + ((row - TCTX) & ~2047); L = 2048; t = (row - TCTX) & 2047; }
    u32x4 wv[2 * HW];
#pragma unroll
    for (int k = 0; k < 2 * HW; ++k) { const int uu = t - HW + k; const bool ok = uu >= 0 && uu < L;
        wv[k] = ok ? *(const u32x4*)(H + (size_t)(sb + uu) * 1024 + c) : (u32x4){0u, 0u, 0u, 0u}; }
    float s[8];
#pragma unroll
    for (int j = 0; j < 8; ++j) s[j] = 0.f;
#pragma unroll
    for (int k = 0; k < 2 * HW; ++k) { const u32x4 w = wv[k];
        s[0] += bf_lo(w.x); s[1] += bf_hi(w.x); s[2] += bf_lo(w.y); s[3] += bf_hi(w.y); s[4] += bf_lo(w.z); s[5] += bf_hi(w.z); s[6] += bf_lo(w.w); s[7] += bf_hi(w.w); }
    const int lo = max(t - HW, 0), hi = min(t + HW, L);
    const float inv = 1.0f / (float)(hi - lo);
    const u32x4 w = wv[HW];
    u32x4 o;
    o.x = cvt_pk_bf16(s[0] * inv - bf_lo(w.x), s[1] * inv - bf_hi(w.x)); o.y = cvt_pk_bf16(s[2] * inv - bf_lo(w.y), s[3] * inv - bf_hi(w.y));
    o.z = cvt_pk_bf16(s[4] * inv - bf_lo(w.z), s[5] * inv - bf_hi(w.z)); o.w = cvt_pk_bf16(s[6] * inv - bf_lo(w.w), s[7] * inv - bf_hi(w.w));
    *(u32x4*)(Dd + (size_t)row * 1024 + c) = o;
}
__device__ void pool_phase(const bf16_t* H, bf16_t* Dd, int r0, int r1) {
    const int tid_ = opaque_tid(); const int wid = tid_ >> 6, lane = tid_ & 63;
    const int nw = (r1 - r0) * 2;
    for (int it = blockIdx.x * 8 + wid; it < nw; it += gridDim.x * 8) {
        const int gi = it & 3, row = r0 + (it >> 2) * 2 + (lane >> 5), c = gi * 256 + (lane & 31) * 8;
        if (gi == 0) pool_item<1>(H, Dd, row, c); else if (gi == 1) pool_item<2>(H, Dd, row, c); else if (gi == 2) pool_item<4>(H, Dd, row, c); else pool_item<8>(H, Dd, row, c);
    }
}

__device__ void stats_phase(const bf16_t* Y, f32x2* ST, int r0) {
    const int tid_ = opaque_tid(); const int wid = tid_ >> 6, lane = tid_ & 63;
    for (int row = r0 + blockIdx.x * 8 + wid; row < TT; row += gridDim.x * 8) {
        const size_t off = (size_t)row * 2048 + lane * 8;
        u32x4 yw[4];
#pragma unroll
        for (int hh = 0; hh < 4; ++hh) yw[hh] = *(const u32x4*)(Y + off + hh * 512);
        float y[4][8], sm[4], vq[4];
#pragma unroll
        for (int hh = 0; hh < 4; ++hh) { y[hh][0] = bf_lo(yw[hh].x); y[hh][1] = bf_hi(yw[hh].x); y[hh][2] = bf_lo(yw[hh].y); y[hh][3] = bf_hi(yw[hh].y); y[hh][4] = bf_lo(yw[hh].z); y[hh][5] = bf_hi(yw[hh].z); y[hh][6] = bf_lo(yw[hh].w); y[hh][7] = bf_hi(yw[hh].w);
            float a = 0.f;
#pragma unroll
            for (int j = 0; j < 8; ++j) a += y[hh][j];
            sm[hh] = a; }
#pragma unroll
        for (int o = 32; o >= 1; o >>= 1)
#pragma unroll
            for (int hh = 0; hh < 4; ++hh) sm[hh] += __int_as_float(__builtin_amdgcn_ds_bpermute((lane ^ o) << 2, __float_as_int(sm[hh])));
#pragma unroll
        for (int hh = 0; hh < 4; ++hh) { const float mu = sm[hh] * (1.0f / 512.0f); float a = 0.f; sm[hh] = mu;
#pragma unroll
            for (int j = 0; j < 8; ++j) { const float d = y[hh][j] - mu; a += d * d; }
            vq[hh] = a; }
#pragma unroll
        for (int o = 32; o >= 1; o >>= 1)
#pragma unroll
            for (int hh = 0; hh < 4; ++hh) vq[hh] += __int_as_float(__builtin_amdgcn_ds_bpermute((lane ^ o) << 2, __float_as_int(vq[hh])));
        if (lane < 4) { const float mu = lane == 0 ? sm[0] : (lane == 1 ? sm[1] : (lane == 2 ? sm[2] : sm[3])); const float v = lane == 0 ? vq[0] : (lane == 1 ? vq[1] : (lane == 2 ? vq[2] : vq[3]));
            ST[(size_t)row * 4 + lane] = (f32x2){mu, rsqrtf(v * (1.0f / 512.0f) + 1e-5f)}; }
    }
}

__device__ __forceinline__ int perm_qk(int c) { const int hh = c >> 8, hf = (c >> 7) & 1, dd = c & 127; return hh * 256 + hf * 128 + (dd & 1) * 64 + (dd >> 1); }

struct ConvD { const float* src; bf16_t* dst; int srcN, K, n0, k0, maptype; };
__device__ __forceinline__ ConvD conv_desc(const Params& p, bf16_t* Wb, int it) {
    int i = it;
    if (i < 1536) { const int j = i / 768, r = i % 768; return ConvD{p.ret_w_in + (size_t)j * 1024 * 6144, Wb + W_RETIN + (size_t)j * 6144 * 1024, 6144, 1024, (r / 8) * 64, (r % 8) * 128, 1}; }
    i -= 1536;
    if (i < 512) { const int j = i / 256, r = i % 256; return ConvD{p.ret_w_out + (size_t)j * 2048 * 1024, Wb + W_RETOUT + (size_t)j * 1024 * 2048, 1024, 2048, (r / 16) * 64, (r % 16) * 128, 0}; }
    i -= 512;
    if (i < 64) { const int jg = i / 8, r = i % 8; return ConvD{p.pool_w + (size_t)jg * 65536, Wb + W_POOL + (size_t)jg * 65536, 256, 256, (r / 2) * 64, (r % 2) * 128, 0}; }
    i -= 64;
    if (i < 2816) { const int l = i / 704, r = i % 704; return ConvD{p.ffn_w_in + (size_t)l * 1024 * 5632, Wb + W_FFNIN + (size_t)l * 5632 * 1024, 5632, 1024, (r / 8) * 64, (r % 8) * 128, 2}; }
    i -= 2816;
    { const int l = i / 352, r = i % 352; return ConvD{p.ffn_w_out + (size_t)l * HID * 1024, Wb + W_FFNOUT + (size_t)l * 1024 * HID, 1024, HID, (r / 22) * 64, (r % 22) * 128, 0}; }
}
__device__ __forceinline__ void conv_load(const ConvD& d, int tid, float (&v)[16]) {
    const int kk = tid >> 6, np = d.n0 + (tid & 63);
    int sc;
    if (d.maptype == 0) sc = np;
    else if (d.maptype == 1) sc = np < 2048 ? 4096 + np : (np < 3072 ? perm_qk(np - 2048) : (np < 4096 ? 1024 + perm_qk(np - 3072) : 2048 + (np - 4096)));
    else sc = ((np >> 7) & 1) * HID + (np >> 8) * 128 + (np & 127);
#pragma unroll
    for (int ps = 0; ps < 16; ++ps) v[ps] = d.src[(size_t)(d.k0 + kk + 8 * ps) * d.srcN + sc];
}
__device__ __forceinline__ void conv_finish(const ConvD& d, int tid, const float (&v)[16], float* lds) {
    { const int kk = tid >> 6, nn = tid & 63;
#pragma unroll
      for (int ps = 0; ps < 16; ++ps) lds[(kk + 8 * ps) * 65 + nn] = v[ps]; }
    __syncthreads();
    { const int nn = tid >> 3, kc = tid & 7;
#pragma unroll
      for (int hh = 0; hh < 2; ++hh) {
        float t[8];
#pragma unroll
        for (int e = 0; e < 8; ++e) t[e] = lds[(64 * hh + 8 * kc + e) * 65 + nn];
        u32x4 w; w.x = cvt_pk_bf16(t[0], t[1]); w.y = cvt_pk_bf16(t[2], t[3]); w.z = cvt_pk_bf16(t[4], t[5]); w.w = cvt_pk_bf16(t[6], t[7]);
        *(u32x4*)(d.dst + (size_t)(d.n0 + nn) * d.K + d.k0 + 64 * hh + 8 * kc) = w; } }
    __syncthreads();
}

__device__ void phase0(const Params& p, float* lds) {
    const int tid = opaque_tid(), wid = tid >> 6, lane = tid & 63;
    float* X = (float*)(p.ws + WS_X);
    bf16_t* Wb = (bf16_t*)((unsigned char*)p.out + OB_W);
    float* MOD = (float*)((unsigned char*)p.out + OB_MOD);
    f32x2* CS = (f32x2*)((unsigned char*)p.out + OB_CS);
    for (int idx = blockIdx.x * 512 + tid; idx < 4096; idx += gridDim.x * 512) {
        const int pos = idx >> 6, pp = idx & 63;
        const float inv = powf(10000.0f, -(float)(2 * pp) / 128.0f);
        const float angf = (float)pos * inv;
        double a = (double)angf;
        const double k = rint(a * 0.6366197723675814);
        const double rr = (a - k * 1.5707963267948966) - k * 6.123233995736766e-17;
        const int qd = ((int)k) & 3;
        const double r2 = rr * rr;
        double sn = rr * (1.0 + r2 * (-1.0 / 6 + r2 * (1.0 / 120 + r2 * (-1.0 / 5040 + r2 * (1.0 / 362880 + r2 * (-1.0 / 39916800 + r2 * (1.0 / 6227020800.0)))))));
        double cn = 1.0 + r2 * (-0.5 + r2 * (1.0 / 24 + r2 * (-1.0 / 720 + r2 * (1.0 / 40320 + r2 * (-1.0 / 3628800 + r2 * (1.0 / 479001600.0 + r2 * (-1.0 / 87178291200.0)))))));
        double cs_, sn_;
        if (qd == 0) { cs_ = cn; sn_ = sn; } else if (qd == 1) { cs_ = -sn; sn_ = cn; } else if (qd == 2) { cs_ = -cn; sn_ = -sn; } else { cs_ = sn; sn_ = -cn; }
        CS[idx] = (f32x2){(float)cs_, (float)sn_};
    }
    for (int it = blockIdx.x; it < 4 * 96; it += gridDim.x) {
        const int layer = it / 96, cb = it % 96;
        for (int idx = tid; idx < 33 * 1024; idx += 512) { const int r = idx >> 10, k = idx & 1023; const float v = r < 32 ? p.c[r * 1024 + k] : p.c_ctx[k]; lds[idx] = silu_f(v); }
        __syncthreads();
        const float* wp = p.ada_w + (size_t)layer * 1024 * 6144 + cb * 64 + lane;
        float acc[33];
#pragma unroll
        for (int r = 0; r < 33; ++r) acc[r] = 0.f;
        for (int k = wid * 128; k < wid * 128 + 128; k += 4) {
            const float w0 = wp[(size_t)k * 6144], w1 = wp[(size_t)(k + 1) * 6144], w2 = wp[(size_t)(k + 2) * 6144], w3 = wp[(size_t)(k + 3) * 6144];
#pragma unroll
            for (int r = 0; r < 33; ++r) { const f32x4 s4 = *(const f32x4*)(lds + r * 1024 + k); acc[r] += s4[0] * w0 + s4[1] * w1 + s4[2] * w2 + s4[3] * w3; }
        }
        __syncthreads();
#pragma unroll
        for (int r = 0; r < 33; ++r) lds[(wid * 33 + r) * 64 + lane] = acc[r];
        __syncthreads();
        for (int idx = tid; idx < 33 * 64; idx += 512) { const int r = idx >> 6, l = idx & 63; float sm = 0.f;
#pragma unroll
            for (int w = 0; w < 8; ++w) sm += lds[(w * 33 + r) * 64 + l];
            MOD[((size_t)layer * 33 + r) * 6144 + cb * 64 + l] = sm + p.ada_b[layer * 6144 + cb * 64 + l]; }
        __syncthreads();
    }
    {
        int it = blockIdx.x;
        if (it < 6336) {
            ConvD cur = conv_desc(p, Wb, it);
            float va[16];
            conv_load(cur, tid, va);
            for (;;) {
                const int nx = it + (int)gridDim.x; const bool has = nx < 6336;
                ConvD nd = cur; float vb[16];
#pragma unroll
                for (int q = 0; q < 16; ++q) vb[q] = 0.f;
                if (has) { nd = conv_desc(p, Wb, nx); conv_load(nd, tid, vb); }
                conv_finish(cur, tid, va, lds);
                if (!has) break;
                cur = nd; it = nx;
#pragma unroll
                for (int q = 0; q < 16; ++q) va[q] = vb[q];
            }
        }
    }
}

constexpr int QS_LD = 264, KS_LD = 272, P_LD = 80, QP_LD = 272;
template <int ST>
__device__ __forceinline__ void kt_issue(unsigned addr, u32x2 (&o)[8]) {
    constexpr int RB = KS_LD * 2;
    asm volatile(
        "ds_read_b64_tr_b16 %0, %8 offset:%9\n\t"
        "ds_read_b64_tr_b16 %1, %8 offset:%10\n\t"
        "ds_read_b64_tr_b16 %2, %8 offset:%11\n\t"
        "ds_read_b64_tr_b16 %3, %8 offset:%12\n\t"
        "ds_read_b64_tr_b16 %4, %8 offset:%13\n\t"
        "ds_read_b64_tr_b16 %5, %8 offset:%14\n\t"
        "ds_read_b64_tr_b16 %6, %8 offset:%15\n\t"
        "ds_read_b64_tr_b16 %7, %8 offset:%16"
        : "=&v"(o[0]), "=&v"(o[1]), "=&v"(o[2]), "=&v"(o[3]), "=&v"(o[4]), "=&v"(o[5]), "=&v"(o[6]), "=&v"(o[7])
        : "v"(addr),
          "n"((0 * 32 + 0) * RB + 32 * (2 * ST)), "n"((0 * 32 + 4) * RB + 32 * (2 * ST)),
          "n"((1 * 32 + 0) * RB + 32 * (2 * ST)), "n"((1 * 32 + 4) * RB + 32 * (2 * ST)),
          "n"((0 * 32 + 0) * RB + 32 * (2 * ST + 1)), "n"((0 * 32 + 4) * RB + 32 * (2 * ST + 1)),
          "n"((1 * 32 + 0) * RB + 32 * (2 * ST + 1)), "n"((1 * 32 + 4) * RB + 32 * (2 * ST + 1))
        : "memory");
}
template <int N>
__device__ __forceinline__ void kt_wait(u32x2 (&o)[8]) {
    asm volatile("s_waitcnt lgkmcnt(%8)" : "+v"(o[0]), "+v"(o[1]), "+v"(o[2]), "+v"(o[3]), "+v"(o[4]), "+v"(o[5]), "+v"(o[6]), "+v"(o[7]) : "n"(N) : "memory");
}
constexpr int VS_LD = 136;
__device__ __forceinline__ void vt_issue(unsigned addr, u32x2 (&o)[4]) {
    constexpr int RB = VS_LD * 2;
    asm volatile(
        "ds_read_b64_tr_b16 %0, %4 offset:%5\n\t"
        "ds_read_b64_tr_b16 %1, %4 offset:%6\n\t"
        "ds_read_b64_tr_b16 %2, %4 offset:%7\n\t"
        "ds_read_b64_tr_b16 %3, %4 offset:%8"
        : "=&v"(o[0]), "=&v"(o[1]), "=&v"(o[2]), "=&v"(o[3])
        : "v"(addr), "n"(0 * RB), "n"(4 * RB), "n"(32 * RB), "n"(36 * RB)
        : "memory");
}
__device__ __forceinline__ void vt_wait(u32x2 (&o)[4]) {
    asm volatile("s_waitcnt lgkmcnt(0)" : "+v"(o[0]), "+v"(o[1]), "+v"(o[2]), "+v"(o[3]) : : "memory");
}
__device__ __forceinline__ bf16x8 kt_frag(const u32x2& a, const u32x2& b) { return __builtin_bit_cast(bf16x8, (u32x4){a.x, a.y, b.x, b.y}); }
template <int ST, bool LAST>
__device__ __forceinline__ void kt_step(unsigned addr, u32x2 (&cur)[8], u32x2 (&nxt)[8], f32x4 (&S)[16], const bf16x8 (&Vs)[2], float Gc) {
    if constexpr (!LAST) kt_issue<ST + 1>(addr, nxt);
    kt_wait<LAST ? 0 : 8>(cur);
    constexpr int m0 = 2 * ST, m1 = 2 * ST + 1;
    S[m0] = S[m0] * Gc; S[m1] = S[m1] * Gc;
    S[m0] = __builtin_amdgcn_mfma_f32_16x16x32_bf16(kt_frag(cur[0], cur[1]), Vs[0], S[m0], 0, 0, 0);
    S[m1] = __builtin_amdgcn_mfma_f32_16x16x32_bf16(kt_frag(cur[4], cur[5]), Vs[0], S[m1], 0, 0, 0);
    S[m0] = __builtin_amdgcn_mfma_f32_16x16x32_bf16(kt_frag(cur[2], cur[3]), Vs[1], S[m0], 0, 0, 0);
    S[m1] = __builtin_amdgcn_mfma_f32_16x16x32_bf16(kt_frag(cur[6], cur[7]), Vs[1], S[m1], 0, 0, 0);
}
template <bool WITH_B>
__device__ __forceinline__ void scan_bc(const bf16_t* Ps, const bf16_t* Qp, int r, int g, const bf16x8 (&Vf)[2], const f32x4 (&S)[16], f32x4 (&o1)[4], f32x4 (&o2)[4]) {
    constexpr int S0 = WITH_B ? 0 : 2;
    u32x4 fb[2][4];
    const bf16_t* pp = Ps + r * P_LD + 8 * g;
    const bf16_t* qp = Qp + r * QP_LD + 8 * g;
    if constexpr (WITH_B) {
#pragma unroll
        for (int nt = 0; nt < 4; ++nt) fb[0][nt] = *(const u32x4*)(pp + 16 * nt * P_LD);
    } else {
#pragma unroll
        for (int nt = 0; nt < 4; ++nt) fb[0][nt] = *(const u32x4*)(qp + 16 * nt * QP_LD);
    }
#pragma unroll
    for (int st = S0; st < 10; ++st) {
        const int nx = st + 1;
        if (nx < 2) {
#pragma unroll
            for (int nt = 0; nt < 4; ++nt) fb[nx & 1][nt] = *(const u32x4*)(pp + 16 * nt * P_LD + 32 * nx);
        } else if (nx < 10) {
#pragma unroll
            for (int nt = 0; nt < 4; ++nt) fb[nx & 1][nt] = *(const u32x4*)(qp + 16 * nt * QP_LD + 32 * (nx - 2));
        }
        if (st < 2) {
#pragma unroll
            for (int nt = 0; nt < 4; ++nt) o1[nt] = __builtin_amdgcn_mfma_f32_16x16x32_bf16(Vf[st], __builtin_bit_cast(bf16x8, fb[st & 1][nt]), o1[nt], 0, 0, 0);
        } else {
            const int T = st - 2;
            u32x4 aw; aw.x = cvt_pk_bf16(S[2 * T][0], S[2 * T][1]); aw.y = cvt_pk_bf16(S[2 * T][2], S[2 * T][3]); aw.z = cvt_pk_bf16(S[2 * T + 1][0], S[2 * T + 1][1]); aw.w = cvt_pk_bf16(S[2 * T + 1][2], S[2 * T + 1][3]);
            const bf16x8 a = __builtin_bit_cast(bf16x8, aw);
#pragma unroll
            for (int nt = 0; nt < 4; ++nt) o2[nt] = __builtin_amdgcn_mfma_f32_16x16x32_bf16(a, __builtin_bit_cast(bf16x8, fb[st & 1][nt]), o2[nt], 0, 0, 0);
        }
        __builtin_amdgcn_sched_barrier(0);
    }
}

__device__ void ret_phase(const Params& p, unsigned char* ldsb, int lj, int half) {
    const int tid0 = opaque_tid(), w = __builtin_amdgcn_readfirstlane(tid0 >> 6), lane0 = tid0 & 63, r0_ = lane0 & 15, g0_ = lane0 >> 4;
    bf16_t* Qs = (bf16_t*)ldsb;
    bf16_t* Ks = Qs + 64 * QS_LD;
    bf16_t* Ps = Ks + 64 * KS_LD;
    bf16_t* Vl = Ps + 64 * P_LD;
    bf16_t* Qp = Vl + 64 * VS_LD;
    const bf16_t* Qg = (const bf16_t*)(p.ws + WS_R1);
    const bf16_t* Kg = Qg + (size_t)TH * 1024;
    const bf16_t* Vg = Kg + (size_t)TH * 1024;
    bf16_t* Y = (bf16_t*)(p.ws + WS_Y);
    const int jb = w & 3, ih = w >> 2;
    for (int item = blockIdx.x; item < 256; item += gridDim.x) {
        const int xq = item & 7, yq = item >> 3, sl = yq & 3, bh = (yq >> 2) * 8 + xq, bl = bh >> 2, h = bh & 3;
        const int bglob = half * 16 + bl;
        const float l2gF = -fabsf(p.ret_log_decay[(lj * 2 + 0) * 4 + h]) * 1.4426950408889634f, l2gB = -fabsf(p.ret_log_decay[(lj * 2 + 1) * 4 + h]) * 1.4426950408889634f;
        for (int pass = 0; pass < 2; ++pass) {
            const int dir = 1 - pass;
            const float lg = -fabsf(p.ret_log_decay[(lj * 2 + dir) * 4 + h]);
            const float l2g = lg * 1.4426950408889634f;
            const float Gc = __builtin_amdgcn_exp2f(64.0f * l2g);
            float ge[8];
#pragma unroll
            for (int e = 0; e < 8; ++e) ge[e] = __builtin_amdgcn_exp2f((dir == 0 ? -(float)e : (float)e) * l2g);
            f32x4 S[16];
#pragma unroll
            for (int i = 0; i < 16; ++i) S[i] = (f32x4){0.f, 0.f, 0.f, 0.f};
            u32x4 sq[4], sk[4]; u32x4 sv[2]; u32x2 yold[4];
            auto spos = [&](int c) -> int { return dir == 0 ? 64 * c : (c < 4 ? 192 - 64 * c : 2496 - 64 * c); };
            auto lrow = [&](int s0) -> int { return s0 < 256 ? bl * 256 + s0 : 4096 + bl * 2048 + (s0 - 256); };
            auto grow = [&](int s0) -> int { return s0 < 256 ? bglob * 256 + s0 : TCTX + bglob * 2048 + (s0 - 256); };
            const unsigned vo_qk = (unsigned)(((tid0 >> 5) * 1024 + (tid0 & 31) * 8) * 2);
            const unsigned vo_v = (unsigned)(((tid0 >> 4) * 2048 + (tid0 & 15) * 8) * 2);
            const unsigned vo_y = (unsigned)((r0_ * 2048 + 4 * g0_) * 2);
            auto issueQ = [&](int c) { const char* bq = (const char*)(Qg + (size_t)lrow(spos(c)) * 1024 + h * 256);
#pragma unroll
                for (int k = 0; k < 4; ++k) sq[k] = *(const u32x4*)(bq + (size_t)k * 32768 + vo_qk); };
            auto issueK = [&](int c) { const char* bk = (const char*)(Kg + (size_t)lrow(spos(c)) * 1024 + h * 256);
#pragma unroll
                for (int k = 0; k < 4; ++k) sk[k] = *(const u32x4*)(bk + (size_t)k * 32768 + vo_qk); };
            auto issueVY = [&](int c) { const char* bv = (const char*)(Vg + (size_t)lrow(spos(c)) * 2048 + h * 512 + sl * 128);
#pragma unroll
                for (int k = 0; k < 2; ++k) sv[k] = *(const u32x4*)(bv + (size_t)k * 131072 + vo_v);
                if (pass == 1) { const char* by = (const char*)(Y + (size_t)grow(spos(c)) * 2048 + h * 512 + sl * 128 + 16 * w);
#pragma unroll
                    for (int nt = 0; nt < 4; ++nt) yold[nt] = *(const u32x2*)(by + (size_t)nt * 65536 + vo_y); } };
            issueQ(0); issueK(0); issueVY(0);
            for (int c = 0; c < 36; ++c) {
                const int s0 = spos(c);
                int tid = tid0, r = r0_, g = g0_; asm volatile("" : "+v"(tid), "+v"(r), "+v"(g));
                const int grow0 = grow(s0);
#pragma unroll
                for (int k = 0; k < 4; ++k) { const int ch = tid + 512 * k, ri = ch >> 5, cc = ch & 31;
                    if (pass == 0) *(u32x4*)(Qs + ri * QS_LD + cc * 8) = sq[k];
                    bf16_t* qd_ = Qp + ri * QP_LD + 32 * (cc >> 2) + 16 * (cc & 1) + 4 * ((cc >> 1) & 1);
                    *(u32x2*)qd_ = (u32x2){sq[k].x, sq[k].y}; *(u32x2*)(qd_ + 8) = (u32x2){sq[k].z, sq[k].w};
                    *(u32x4*)(Ks + ri * KS_LD + cc * 8) = sk[k]; }
#pragma unroll
                for (int k = 0; k < 2; ++k) { const int ch = tid + 512 * k, ri = ch >> 4, cc = ch & 15; *(u32x4*)(Vl + ri * VS_LD + cc * 8) = sv[k]; }
                u32x2 yo[4];
#pragma unroll
                for (int nt = 0; nt < 4; ++nt) yo[nt] = yold[nt];
                __syncthreads();
                u32x2 vv[4];
                vt_issue((unsigned)(size_t)Vl + (unsigned)(((8 * g + (r >> 2)) * VS_LD + 16 * w + 4 * (r & 3)) * 2), vv);
                if (c + 1 < 36) issueQ(c + 1);
                vt_wait(vv);
                bf16x8 Vf[2], Vs[2];
#pragma unroll
                for (int t = 0; t < 2; ++t) {
                    const u32x4 vft = (u32x4){vv[2 * t].x, vv[2 * t].y, vv[2 * t + 1].x, vv[2 * t + 1].y};
                    Vf[t] = __builtin_bit_cast(bf16x8, vft);
                    const int j0 = 32 * t + 8 * g;
                    const float base = __builtin_amdgcn_exp2f((dir == 0 ? (float)(63 - j0) : (float)j0) * l2g);
                    const unsigned uu[4] = {vft.x, vft.y, vft.z, vft.w};
                    unsigned oo[4];
#pragma unroll
                    for (int e2 = 0; e2 < 4; ++e2) oo[e2] = cvt_pk_bf16(bf_lo(uu[e2]) * (base * ge[2 * e2]), bf_hi(uu[e2]) * (base * ge[2 * e2 + 1]));
                    Vs[t] = __builtin_bit_cast(bf16x8, (u32x4){oo[0], oo[1], oo[2], oo[3]});
                }
                const bool deadout = (lj == 1) && (s0 < 256);
                if (pass == 0 && !deadout) {
                    f32x4 sc[2] = {(f32x4){0.f, 0.f, 0.f, 0.f}, (f32x4){0.f, 0.f, 0.f, 0.f}};
                    const bf16_t* kp = Ks + (16 * jb + r) * KS_LD + 8 * g;
                    const bf16_t* qp0 = Qs + (32 * ih + r) * QS_LD + 8 * g;
                    bf16x8 ka[2], qb[2][2];
                    ka[0] = *(const bf16x8*)kp; qb[0][0] = *(const bf16x8*)qp0; qb[0][1] = *(const bf16x8*)(qp0 + 16 * QS_LD);
#pragma unroll
                    for (int t = 0; t < 8; ++t) {
                        if (t + 1 < 8) { ka[(t + 1) & 1] = *(const bf16x8*)(kp + 32 * (t + 1)); qb[(t + 1) & 1][0] = *(const bf16x8*)(qp0 + 32 * (t + 1)); qb[(t + 1) & 1][1] = *(const bf16x8*)(qp0 + 16 * QS_LD + 32 * (t + 1)); }
                        sc[0] = __builtin_amdgcn_mfma_f32_16x16x32_bf16(ka[t & 1], qb[t & 1][0], sc[0], 0, 0, 0);
                        sc[1] = __builtin_amdgcn_mfma_f32_16x16x32_bf16(ka[t & 1], qb[t & 1][1], sc[1], 0, 0, 0);
                        __builtin_amdgcn_sched_barrier(0);
                    }
#pragma unroll
                    for (int nt = 0; nt < 2; ++nt) { const int i = 32 * ih + 16 * nt + r; const int j0 = 16 * jb + 4 * g;
                        float pv[4];
#pragma unroll
                        for (int jj = 0; jj < 4; ++jj) { const int df = j0 + jj - i;
                            pv[jj] = sc[nt][jj] * __builtin_amdgcn_exp2f(df > 0 ? (float)df * l2gB : (float)(-df) * l2gF); }
                        u32x2 o; o.x = cvt_pk_bf16(pv[0], pv[1]); o.y = cvt_pk_bf16(pv[2], pv[3]);
                        *(u32x2*)(Ps + i * P_LD + j0) = o; }
                }
                if (c + 1 < 36) issueK(c + 1);
                f32x4 o1[4], o2[4];
#pragma unroll
                for (int nt = 0; nt < 4; ++nt) { o1[nt] = (f32x4){0.f, 0.f, 0.f, 0.f}; o2[nt] = (f32x4){0.f, 0.f, 0.f, 0.f}; }
                if (!deadout) {
                    if (pass == 0) { __syncthreads(); scan_bc<true>(Ps, Qp, r, g, Vf, S, o1, o2); }
                    else if (c > 0) scan_bc<false>(Ps, Qp, r, g, Vf, S, o1, o2);
                }
                if (c + 1 < 36) issueVY(c + 1);
                if (c < 35) {
                    u32x2 fa0[8], fa1[8];
                    const unsigned kaddr = (unsigned)(size_t)Ks + (unsigned)(((8 * g + (r >> 2)) * KS_LD + 4 * (r & 3)) * 2);
                    kt_issue<0>(kaddr, fa0);
                    kt_step<0, false>(kaddr, fa0, fa1, S, Vs, Gc);
                    kt_step<1, false>(kaddr, fa1, fa0, S, Vs, Gc);
                    kt_step<2, false>(kaddr, fa0, fa1, S, Vs, Gc);
                    kt_step<3, false>(kaddr, fa1, fa0, S, Vs, Gc);
                    kt_step<4, false>(kaddr, fa0, fa1, S, Vs, Gc);
                    kt_step<5, false>(kaddr, fa1, fa0, S, Vs, Gc);
                    kt_step<6, false>(kaddr, fa0, fa1, S, Vs, Gc);
                    kt_step<7, true>(kaddr, fa1, fa0, S, Vs, Gc);
                }
                if (!deadout)
#pragma unroll
                for (int nt = 0; nt < 4; ++nt) { const int i = 16 * nt + r;
                    const float qd = __builtin_amdgcn_exp2f((dir == 0 ? (float)(i + 1) : (float)(64 - i)) * l2g);
                    f32x4 yv = o1[nt] + o2[nt] * qd;
                    bf16_t* yp = (bf16_t*)((char*)(Y + (size_t)grow0 * 2048 + h * 512 + sl * 128 + 16 * w) + (size_t)nt * 65536 + vo_y);
                    if (pass == 1) { yv[0] += bf_lo(yo[nt].x); yv[1] += bf_hi(yo[nt].x); yv[2] += bf_lo(yo[nt].y); yv[3] += bf_hi(yo[nt].y); }
                    u32x2 o; o.x = cvt_pk_bf16(yv[0], yv[1]); o.y = cvt_pk_bf16(yv[2], yv[3]);
                    *(u32x2*)yp = o; }
                __syncthreads();
            }
        }
    }
}

__device__ __forceinline__ void gbar(unsigned* ctr, unsigned& target) {
    asm volatile("s_waitcnt vmcnt(0) lgkmcnt(0)" ::: "memory");
    __syncthreads();
    target += gridDim.x;
    if (threadIdx.x == 0) {
        __builtin_amdgcn_fence(__ATOMIC_RELEASE, "agent");
        asm volatile("s_waitcnt vmcnt(0)" ::: "memory");
        __hip_atomic_fetch_add(ctr, 1u, __ATOMIC_RELAXED, __HIP_MEMORY_SCOPE_AGENT);
        while (__hip_atomic_load(ctr, __ATOMIC_RELAXED, __HIP_MEMORY_SCOPE_AGENT) < target) __builtin_amdgcn_s_sleep(2);
        __builtin_amdgcn_fence(__ATOMIC_ACQUIRE, "agent");
        asm volatile("s_waitcnt vmcnt(0)" ::: "memory");
    }
    __syncthreads();
}

__global__ void __launch_bounds__(512, 2) mega(Params p) {
    extern __shared__ __attribute__((aligned(16))) unsigned char shm[];
    cg::grid_group grid = cg::this_grid();
    LAS unsigned char* lds = (LAS unsigned char*)shm;
    float* X = (float*)(p.ws + WS_X);
    unsigned char* R1 = p.ws + WS_R1;
    bf16_t* Y = (bf16_t*)(p.ws + WS_Y);
    bf16_t* H = (bf16_t*)((unsigned char*)p.out + OB_H);
    const bf16_t* Wb = (const bf16_t*)((unsigned char*)p.out + OB_W);
    const float* MOD = (const float*)((unsigned char*)p.out + OB_MOD);
    const f32x2* CS = (const f32x2*)((unsigned char*)p.out + OB_CS);
    const TileMap idm = {1 << 30, 0, 0};
    unsigned* bar = (unsigned*)(p.ws + WS_BAR); unsigned btarget = 0;

    phase0(p, (float*)shm);
    grid.sync();

    for (int layer = 0; layer < 4; ++layer) {
        const bool last = layer == 3;
        const bool use_ret = (layer & 1) == 0;
        const int lj = layer >> 1;
        const float* modl = MOD + (size_t)layer * 33 * 6144;
        const int r0 = last ? TCTX : 0;
        const TileMap rowmap = last ? TileMap{0, 0, 32} : idm;
        const int Mrows = last ? (TT - TCTX) : TT;
        const bool latpost = layer >= 2;
        const int r0p = latpost ? TCTX : 0;
        const TileMap rowmapp = latpost ? TileMap{0, 0, 32} : idm;
        const int Mrowsp = latpost ? (TT - TCTX) : TT;

        const float* Xc = layer == 0 ? p.ctx : X; const float* Xl = layer == 0 ? p.x - (size_t)TCTX * 1024 : X;
        norm_phase(Xc, Xl, H, p.norm1_w + layer * 1024, modl, 0, 1, r0, TT);
        gbar(bar, btarget);

        if (use_ret) {
            const bf16_t* Win = Wb + W_RETIN + (size_t)lj * 6144 * 1024;
            bf16_t* Qg = (bf16_t*)R1; bf16_t* Kg = Qg + (size_t)TH * 1024; bf16_t* VTg = Kg + (size_t)TH * 1024;
            for (int half = 0; half < 2; ++half) {
                const TileMap hm = {16, 16 * half, 32 + 128 * half};
                { Gemm g = {H, Win + (size_t)2048 * 1024, 1024, 1024, TH, 4096, 1024, hm, idm, 0};
                  EpiQK E = {Qg, Kg, VTg, CS, hm};
                  pg8::gemm_phase(lds, g, E); }
                gbar(bar, btarget);
                ret_phase(p, shm, lj, half);
                gbar(bar, btarget);
            }
            stats_phase(Y, (f32x2*)(p.ws + WS_ST), r0p);
            gbar(bar, btarget);
            { Gemm g = {H, Win, 1024, 1024, Mrowsp, 2048, 1024, rowmapp, idm, 0};
              EpiSiluGN E = {(bf16_t*)R1, rowmapp, Y, (const f32x2*)(p.ws + WS_ST), p.ret_gn_w + lj * 2048};
              pg8::gemm_phase(lds, g, E); }
            gbar(bar, btarget);
            { Gemm g = {(const bf16_t*)R1, Wb + W_RETOUT + (size_t)lj * 1024 * 2048, 2048, 2048, Mrowsp, 1024, 2048, rowmapp, idm, 0};
              EpiRes E = {X, Xc, Xl, modl, 2, nullptr, rowmapp};
              pg8::gemm_phase(lds, g, E); }
            gbar(bar, btarget);
        } else {
            pool_phase(H, (bf16_t*)R1, r0, TT);
            gbar(bar, btarget);
            { Gemm g = {(const bf16_t*)R1, Wb + W_POOL + (size_t)lj * 262144, 1024, 256, Mrows, 1024, 256, rowmap, idm, 512};
              EpiRes E = {X, X, X, modl, 2, p.pool_scale + lj * 1024, rowmap};
              pg8::gemm_phase(lds, g, E); }
            gbar(bar, btarget);
        }

        norm_phase(X, X, H, p.norm2_w + layer * 1024, modl, 3, 4, r0p, TT);
        gbar(bar, btarget);
        { Gemm g = {H, Wb + W_FFNIN + (size_t)layer * 5632 * 1024, 1024, 1024, Mrowsp, 5632, 1024, rowmapp, idm, 0};
          EpiSwiglu E = {(bf16_t*)R1, rowmapp};
          pg8::gemm_phase(lds, g, E); }
        gbar(bar, btarget);
        { Gemm g = {(const bf16_t*)R1, Wb + W_FFNOUT + (size_t)layer * 1024 * HID, HID, HID, Mrowsp, 1024, HID, rowmapp, idm, 0};
          EpiRes E = {X, X, X, modl, 5, nullptr, rowmapp};
          pg8::gemm_phase(lds, g, E); }
        gbar(bar, btarget);
    }
    final_norm_phase(X, p.out, p.final_norm_w);
}

extern "C" void kernel_launch(void* const* d_in, const int* in_sizes, int n_in, void* d_out, int out_size, void* d_ws, size_t ws_size, hipStream_t stream) {
    static int grid_blocks = 0;
    if (!grid_blocks) {
        if (ws_size < WS_END || n_in < 17) { fprintf(stderr, "kernel_launch: workspace too small (%zu < %zu) or n_in %d\n", ws_size, (size_t)WS_END, n_in); grid_blocks = -1; return; }
        int dev = 0, cus = 0, per_cu = 0;
        hipGetDevice(&dev);
        hipDeviceGetAttribute(&cus, hipDeviceAttributeMultiprocessorCount, dev);
        if (hipFuncSetAttribute((const void*)mega, hipFuncAttributeMaxDynamicSharedMemorySize, LDS_BYTES) != hipSuccess) { fprintf(stderr, "kernel_launch: hipFuncSetAttribute failed\n"); grid_blocks = -1; return; }
        hipOccupancyMaxActiveBlocksPerMultiprocessor(&per_cu, (const void*)mega, 512, LDS_BYTES);
        if (per_cu < 1) { fprintf(stderr, "kernel_launch: occupancy query returned %d\n", per_cu); per_cu = 1; }
        grid_blocks = cus * per_cu;
    }
    if (grid_blocks < 0) return;
    Params p{};
    p.x = (const float*)d_in[0]; p.c = (const float*)d_in[1]; p.ctx = (const float*)d_in[2]; p.c_ctx = (const float*)d_in[3];
    p.ada_w = (const float*)d_in[4]; p.ada_b = (const float*)d_in[5]; p.norm1_w = (const float*)d_in[6]; p.norm2_w = (const float*)d_in[7];
    p.ret_w_in = (const float*)d_in[8]; p.ret_log_decay = (const float*)d_in[9]; p.ret_gn_w = (const float*)d_in[10]; p.ret_w_out = (const float*)d_in[11];
    p.pool_w = (const float*)d_in[12]; p.pool_scale = (const float*)d_in[13]; p.ffn_w_in = (const float*)d_in[14]; p.ffn_w_out = (const float*)d_in[15];
    p.final_norm_w = (const float*)d_in[16];
    p.out = (float*)d_out; p.ws = (unsigned char*)d_ws;
    if (hipMemsetAsync((unsigned char*)d_ws + WS_BAR, 0, 256, stream) != hipSuccess) { fprintf(stderr, "kernel_launch: memset failed\n"); return; }
    void* args[] = {&p};
    hipError_t e = hipLaunchCooperativeKernel((const void*)mega, dim3(grid_blocks), dim3(512), args, LDS_BYTES, stream);
    if (e != hipSuccess) fprintf(stderr, "cooperative launch failed: %s (grid %d)\n", hipGetErrorString(e), grid_blocks);
}
```

```cpp
#include <hip/hip_runtime.h>
#include <hip/hip_cooperative_groups.h>
#include <cstdio>
namespace cg = cooperative_groups;

#define LAS __attribute__((address_space(3)))
typedef unsigned short bf16_t;
typedef short bf16x8 __attribute__((ext_vector_type(8)));
typedef float f32x4 __attribute__((ext_vector_type(4)));
typedef float f32x2 __attribute__((ext_vector_type(2)));
typedef unsigned u32x4 __attribute__((ext_vector_type(4)));
typedef unsigned u32x2 __attribute__((ext_vector_type(2)));

constexpr int DM = 1024, NB = 32, SEQ = 2048, CTXL = 256, HID = 2816;
constexpr int TCTX = NB * CTXL;
constexpr int TT = TCTX + NB * SEQ;
constexpr int TH = TT / 2;
constexpr int LDS_BYTES = 135168;

constexpr size_t WS_X = 0;
constexpr size_t WS_R1 = 301989888ull;
constexpr size_t WS_Y = WS_R1 + 377487360ull;
constexpr size_t WS_BAR = WS_Y + 301989888ull;
constexpr size_t WS_ST = WS_BAR + 256;
constexpr size_t WS_END = WS_ST + 2359296ull;
constexpr size_t OB_H = 0;
constexpr size_t OB_W = 150994944ull;
constexpr size_t OB_MOD = 254803968ull;
constexpr size_t OB_CS = 258048000ull;
constexpr size_t W_RETIN = 0, W_RETOUT = 12582912ull, W_POOL = 16777216ull, W_FFNIN = 17301504ull, W_FFNOUT = 40370176ull;

struct Params {
    const float *x, *c, *ctx, *c_ctx, *ada_w, *ada_b, *norm1_w, *norm2_w, *ret_w_in, *ret_log_decay, *ret_gn_w, *ret_w_out, *pool_w, *pool_scale, *ffn_w_in, *ffn_w_out, *final_norm_w;
    float* out; unsigned char* ws;
};

__device__ __forceinline__ unsigned cvt_pk_bf16(float lo, float hi) { unsigned r; asm("v_cvt_pk_bf16_f32 %0, %1, %2" : "=v"(r) : "v"(lo), "v"(hi)); return r; }
__device__ __forceinline__ float bf_lo(unsigned u) { return __uint_as_float(u << 16); }
__device__ __forceinline__ float bf_hi(unsigned u) { return __uint_as_float(u & 0xffff0000u); }
__device__ __forceinline__ int opaque_tid() { int t = threadIdx.x; asm volatile("" : "+v"(t)); return t; }
__device__ __forceinline__ float silu_f(float v) { return v * __builtin_amdgcn_rcpf(1.0f + __expf(-v)); }
__device__ __forceinline__ f32x4 silu4(f32x4 v) {
    f32x4 e, r;
#pragma unroll
    for (int j = 0; j < 4; ++j) e[j] = __builtin_amdgcn_exp2f(v[j] * -1.4426950408889634f);
#pragma unroll
    for (int j = 0; j < 4; ++j) r[j] = __builtin_amdgcn_rcpf(1.0f + e[j]);
    return v * r;
}

namespace pg8 {
constexpr int BM = 256, BK = 64, HALF = 128, HTB = HALF * BK * 2, STAGE_BYTES = 8 * HTB, NXCD = 8, WGM = 4;
__host__ __device__ __forceinline__ int lds_byte(int r, int c) { const int st = (r >> 4) * 2 + (c >> 5), rr = r & 15, cc = c & 31, ob = rr * 64 + cc * 2; return st * 1024 + (ob ^ (((ob >> 9) & 1) << 5)); }
__host__ __device__ __forceinline__ void stage_rc(int b, int& R, int& C) { const int st = b / 1024, sb = b % 1024, swz = sb ^ (((sb >> 9) & 1) << 5); R = (st >> 1) * 16 + swz / 64; C = (st & 1) * 32 + (swz % 64) / 2; }
__host__ __device__ __forceinline__ int perm32(int rho) { const int n = rho >> 4, i = rho & 15; return 8 * (i >> 2) + 4 * n + (i & 3); }

struct Unit { int pm, pn; };
struct TileMap { int nctx, ctx0, lat0; __device__ __forceinline__ int src(int t) const { return t < nctx ? ctx0 + t : lat0 + (t - nctx); } };
struct Gemm { const bf16_t* A; const bf16_t* Bt; int lda, ldb, M, N, K; TileMap mapA, mapB; int a_pn_step; };

struct StaticOrder {
    int nM, nN, nwg, G, c;
    __device__ void init(int M, int N, int G_, int c_) { nM = M / BM; nN = N / BM; nwg = nM * nN; G = G_; c = c_; }
    __device__ bool next(int i, Unit& u) const {
        const long L = (long)i * G + c; if (L >= nwg) return false;
        int wgid = (int)L; { const int q = nwg / NXCD, r = nwg % NXCD, xcd = wgid % NXCD, off = wgid / NXCD; wgid = (xcd < r ? xcd * (q + 1) : r * (q + 1) + (xcd - r) * q) + off; }
        const int nig = WGM * nN, gid = wgid / nig, fm = gid * WGM, gsz = (nM - fm) < WGM ? (nM - fm) : WGM;
        u.pm = fm + ((wgid % nig) % gsz); u.pn = (wgid % nig) / gsz; return true;
    }
};

template <class Epi>
__device__ __forceinline__ void gemm_phase(LAS unsigned char* lds, const Gemm g, const Epi& E) {
    const int tid = opaque_tid(), wid = __builtin_amdgcn_readfirstlane(tid >> 6), lane = tid & 63, wr = wid >> 2, wc = wid & 3, fr = lane & 15, fq = lane >> 4;
    const int K = g.K, nt = K / BK;
    StaticOrder S; S.init(g.M, g.N, (int)gridDim.x, (int)blockIdx.x);
    unsigned voffA[2], voffB[2];
#pragma unroll
    for (int i = 0; i < 2; ++i) { int R, C; stage_rc(tid * 16 + i * 8192, R, C); const int Rb = Epi::PERM ? ((R & ~31) + perm32(R & 31)) : R;
        voffA[i] = (unsigned)(R * g.lda + C) * 2u; voffB[i] = (unsigned)(Rb * g.ldb + C) * 2u; }
    const size_t kstep = (size_t)(BK * 2);
    const size_t hstepA = (size_t)HALF * g.lda * 2, hstepB = (size_t)HALF * g.ldb * 2;
    const size_t tstepA = 2 * hstepA, tstepB = 2 * hstepB;
    const unsigned ldsw = (unsigned)wid * 1024u;
    const int aoff = lds_byte(wr * 64 + fr, fq * 8), boff = lds_byte(wc * 32 + fr, fq * 8);
#define PG8_SA(b, h) (((b) * 2 + (h)) * HTB)
#define PG8_SB(b, h) ((4 + (b) * 2 + (h)) * HTB)
#define PG8_STAGE(bufoff, gbase, voff) do { _Pragma("unroll") for (int _i = 0; _i < 2; ++_i) \
        __builtin_amdgcn_global_load_lds((const unsigned*)((const char*)(gbase) + (voff)[_i]), (LAS unsigned*)(lds + (bufoff) + ldsw + _i * 8192), 16, 0, 0); } while (0)
#define PG8_LDA(dst, b, h) do { _Pragma("unroll") for (int m = 0; m < 4; ++m) _Pragma("unroll") for (int k = 0; k < 2; ++k) dst[m][k] = *(const LAS bf16x8*)(lds + PG8_SA(b, h) + aoff + m * 2048 + k * 1024); } while (0)
#define PG8_LDB(dst, b, h) do { _Pragma("unroll") for (int n = 0; n < 2; ++n) _Pragma("unroll") for (int k = 0; k < 2; ++k) dst[n][k] = *(const LAS bf16x8*)(lds + PG8_SB(b, h) + boff + n * 2048 + k * 1024); } while (0)
#define PG8_MMA(ai, bj, At, Bt) do { __builtin_amdgcn_s_setprio(1); _Pragma("unroll") for (int m = 0; m < 4; ++m) _Pragma("unroll") for (int n = 0; n < 2; ++n) _Pragma("unroll") for (int k = 0; k < 2; ++k) \
        acc[ai][bj][m][n] = __builtin_amdgcn_mfma_f32_16x16x32_bf16(Bt[n][k], At[m][k], acc[ai][bj][m][n], 0, 0, 0); __builtin_amdgcn_s_setprio(0); } while (0)
#define PG8_WAIT_V(n) asm volatile("s_waitcnt vmcnt(" #n ")" ::: "memory")
#define PG8_WAIT_L(n) asm volatile("s_waitcnt lgkmcnt(" #n ")" ::: "memory")
#define PG8_BAR __builtin_amdgcn_s_barrier()
#define PG8_SCHED __builtin_amdgcn_sched_barrier(0)
    Unit cur, nxt; int ui = 0;
    if (!S.next(0, cur)) return;
    f32x4 acc[2][2][4][2];
#pragma unroll
    for (int a = 0; a < 2; ++a)
#pragma unroll
        for (int b = 0; b < 2; ++b)
#pragma unroll
            for (int m = 0; m < 4; ++m)
#pragma unroll
                for (int n = 0; n < 2; ++n) acc[a][b][m][n] = (f32x4){0.f, 0.f, 0.f, 0.f};
    bf16x8 At[4][2], B0[2][2], B1[2][2];
    const char* cA = (const char*)g.A + (size_t)g.mapA.src(cur.pm) * tstepA + (size_t)cur.pn * g.a_pn_step;
    const char* cB = (const char*)g.Bt + (size_t)g.mapB.src(cur.pn) * tstepB;
    PG8_STAGE(PG8_SB(0, 0), cB, voffB); PG8_STAGE(PG8_SA(0, 0), cA, voffA); PG8_STAGE(PG8_SB(0, 1), cB + hstepB, voffB); PG8_STAGE(PG8_SA(0, 1), cA + hstepA, voffA);
    if (wr == 1) PG8_BAR;
    PG8_WAIT_V(4); PG8_BAR;
    PG8_STAGE(PG8_SB(1, 0), cB + kstep, voffB); PG8_STAGE(PG8_SA(1, 0), cA + kstep, voffA); PG8_STAGE(PG8_SB(1, 1), cB + hstepB + kstep, voffB);
    PG8_WAIT_V(6); PG8_BAR;
    for (;;) {
        const bool has_next = S.next(ui + 1, nxt);
        const char* nA = has_next ? (const char*)g.A + (size_t)g.mapA.src(nxt.pm) * tstepA + (size_t)nxt.pn * g.a_pn_step : cA;
        const char* nB = has_next ? (const char*)g.Bt + (size_t)g.mapB.src(nxt.pn) * tstepB : cB;
        for (int t = 0; t < nt; t += 2) {
            const bool last = (t == nt - 2);
            const char* a1 = cA + (size_t)(t + 1) * kstep;
            const char* a2 = last ? nA : cA + (size_t)(t + 2) * kstep; const char* b2 = last ? nB : cB + (size_t)(t + 2) * kstep;
            const char* a3 = a2 + kstep; const char* b3 = b2 + kstep;
            PG8_LDB(B0, 0, 0); PG8_SCHED; PG8_LDA(At, 0, 0); PG8_STAGE(PG8_SA(1, 1), a1 + hstepA, voffA);
            PG8_WAIT_L(8); PG8_BAR; PG8_WAIT_L(0); PG8_MMA(0, 0, At, B0); PG8_BAR; PG8_SCHED;
            PG8_LDB(B1, 0, 1); PG8_STAGE(PG8_SB(0, 0), b2, voffB);
            PG8_BAR; PG8_WAIT_L(0); PG8_MMA(0, 1, At, B1); PG8_BAR;
            PG8_LDA(At, 0, 1); PG8_STAGE(PG8_SA(0, 0), a2, voffA);
            PG8_BAR; PG8_WAIT_L(0); PG8_MMA(1, 0, At, B0); PG8_BAR; PG8_SCHED;
            PG8_STAGE(PG8_SB(0, 1), b2 + hstepB, voffB);
            PG8_WAIT_V(6); PG8_BAR; PG8_MMA(1, 1, At, B1); PG8_BAR;
            PG8_LDB(B0, 1, 0); PG8_SCHED; PG8_LDA(At, 1, 0); PG8_STAGE(PG8_SA(0, 1), a2 + hstepA, voffA);
            PG8_WAIT_L(8); PG8_BAR; PG8_WAIT_L(0); PG8_MMA(0, 0, At, B0); PG8_BAR; PG8_SCHED;
            PG8_LDB(B1, 1, 1); PG8_STAGE(PG8_SB(1, 0), b3, voffB);
            PG8_BAR; PG8_WAIT_L(0); PG8_MMA(0, 1, At, B1); PG8_BAR;
            PG8_LDA(At, 1, 1); PG8_STAGE(PG8_SA(1, 0), a3, voffA);
            PG8_BAR; PG8_WAIT_L(0); PG8_MMA(1, 0, At, B0); PG8_BAR; PG8_SCHED;
            PG8_STAGE(PG8_SB(1, 1), b3 + hstepB, voffB);
            PG8_WAIT_V(6); PG8_BAR; PG8_MMA(1, 1, At, B1); PG8_BAR;
        }
        E(acc, cur, wr, wc, fr, fq);
        if (!has_next) break;
#pragma unroll
        for (int a = 0; a < 2; ++a)
#pragma unroll
            for (int b = 0; b < 2; ++b)
#pragma unroll
                for (int m = 0; m < 4; ++m)
#pragma unroll
                    for (int n = 0; n < 2; ++n) acc[a][b][m][n] = (f32x4){0.f, 0.f, 0.f, 0.f};
        cur = nxt; cA = nA; cB = nB; ++ui;
    }
    PG8_WAIT_V(0);
    if (wr == 0) PG8_BAR;
    PG8_BAR;
#undef PG8_SA
#undef PG8_SB
#undef PG8_STAGE
#undef PG8_LDA
#undef PG8_LDB
#undef PG8_MMA
#undef PG8_WAIT_V
#undef PG8_WAIT_L
#undef PG8_BAR
#undef PG8_SCHED
}
}
using pg8::Unit; using pg8::TileMap; using pg8::Gemm;

typedef f32x4 AccT[2][2][4][2];

struct EpiRes {
    static constexpr bool PERM = false;
    float* X; const float* Xc; const float* Xl; const float* modl; int gi; const float* scale; TileMap mapA;
    __device__ __forceinline__ void operator()(const AccT& acc, const Unit& u, int wr, int wc, int fr, int fq) const {
        asm volatile("" : "+v"(fr), "+v"(fq));
        const int gpm = mapA.src(u.pm);
        const int mb = gpm < 32 ? 32 : (gpm - 32) >> 3;
        const int row0 = gpm * 256 + wr * 64 + fr, col0 = u.pn * 256 + wc * 32 + 4 * fq;
        const float* gp = modl + ((size_t)mb * 6 + gi) * 1024;
        f32x4 gv[2][2];
#pragma unroll
        for (int bj = 0; bj < 2; ++bj)
#pragma unroll
            for (int n = 0; n < 2; ++n) { gv[bj][n] = *(const f32x4*)(gp + col0 + bj * 128 + n * 16); if (scale) gv[bj][n] = gv[bj][n] * *(const f32x4*)(scale + col0 + bj * 128 + n * 16); }
        const float* sbase = (gpm < 32 ? Xc : Xl) + (size_t)row0 * 1024 + col0;
#pragma unroll
        for (int ai = 0; ai < 2; ++ai) {
            f32x4 xo[4][2][2];
#pragma unroll
            for (int m = 0; m < 4; ++m)
#pragma unroll
                for (int bj = 0; bj < 2; ++bj)
#pragma unroll
                    for (int n = 0; n < 2; ++n) xo[m][bj][n] = *(const f32x4*)(sbase + (size_t)(ai * 128 + m * 16) * 1024 + bj * 128 + n * 16);
            __builtin_amdgcn_sched_barrier(0);
#pragma unroll
            for (int m = 0; m < 4; ++m) { float* rowp = X + (size_t)(row0 + ai * 128 + m * 16) * 1024 + col0;
#pragma unroll
                for (int bj = 0; bj < 2; ++bj)
#pragma unroll
                    for (int n = 0; n < 2; ++n) *(f32x4*)(rowp + bj * 128 + n * 16) = xo[m][bj][n] + gv[bj][n] * acc[ai][bj][m][n]; }
            __builtin_amdgcn_sched_barrier(0);
        }
    }
};

struct EpiQK {
    static constexpr bool PERM = true;
    bf16_t* Q; bf16_t* Kk; bf16_t* Vv; const f32x2* cs; TileMap mapA;
    __device__ __forceinline__ void operator()(const AccT& acc, const Unit& u, int wr, int wc, int fr, int fq) const {
        asm volatile("" : "+v"(fr), "+v"(fq));
        const int gpm = mapA.src(u.pm);
        const bool isq = u.pn < 4, isv = u.pn >= 8;
        const bool lat = gpm >= 32 && !isv;
        bf16_t* base = isq ? Q : (isv ? Vv + (size_t)(u.pn - 8) * 256 : Kk);
        const int hh = isv ? 0 : (u.pn & 3);
        const int ldo = isv ? 2048 : 1024;
        const float osc = isq ? 0.0625f : 1.0f;
        const int p0 = 16 * wc + 4 * fq;
        f32x4 ctR[2][2], ctC[4][2];
        if (lat) {
#pragma unroll
            for (int ai = 0; ai < 2; ++ai) { const int pr = ((gpm - 32) * 4 + 2 * ai + wr) & 31;
                ctR[ai][0] = *(const f32x4*)(cs + pr * 64 + p0); ctR[ai][1] = *(const f32x4*)(cs + pr * 64 + p0 + 2); }
#pragma unroll
            for (int m = 0; m < 4; ++m) { const int pc = m * 16 + fr;
                ctC[m][0] = *(const f32x4*)(cs + pc * 64 + p0); ctC[m][1] = *(const f32x4*)(cs + pc * 64 + p0 + 2); }
        }
        __builtin_amdgcn_sched_barrier(0);
#pragma unroll
        for (int ai = 0; ai < 2; ++ai)
#pragma unroll
            for (int m = 0; m < 4; ++m) {
                const int rl = ai * 128 + wr * 64 + m * 16 + fr;
                bf16_t* rowp = base + (size_t)(u.pm * 256 + rl) * ldo + hh * 256 + wc * 32 + 8 * fq;
#pragma unroll
                for (int bj = 0; bj < 2; ++bj) {
                    f32x4 v0 = acc[ai][bj][m][0], v1 = acc[ai][bj][m][1];
                    if (lat) {
                        const f32x4 c01 = bj ? ctC[m][0] : ctR[ai][0], c23 = bj ? ctC[m][1] : ctR[ai][1];
                        f32x4 r0, r1;
                        r0[0] = v0[0] * c01[0] - v0[1] * c01[1]; r0[1] = v0[0] * c01[1] + v0[1] * c01[0];
                        r0[2] = v0[2] * c01[2] - v0[3] * c01[3]; r0[3] = v0[2] * c01[3] + v0[3] * c01[2];
                        r1[0] = v1[0] * c23[0] - v1[1] * c23[1]; r1[1] = v1[0] * c23[1] + v1[1] * c23[0];
                        r1[2] = v1[2] * c23[2] - v1[3] * c23[3]; r1[3] = v1[2] * c23[3] + v1[3] * c23[2];
                        v0 = r0; v1 = r1;
                    }
                    v0 = v0 * osc; v1 = v1 * osc;
                    u32x4 w; w.x = cvt_pk_bf16(v0[0], v0[1]); w.y = cvt_pk_bf16(v0[2], v0[3]); w.z = cvt_pk_bf16(v1[0], v1[1]); w.w = cvt_pk_bf16(v1[2], v1[3]);
                    *(u32x4*)(rowp + bj * 128) = w;
                }
            }
    }
};

struct EpiSiluGN {
    static constexpr bool PERM = true;
    bf16_t* A2; TileMap mapA; const bf16_t* Y; const f32x2* ST; const float* gnw;
    __device__ __forceinline__ void operator()(const AccT& acc, const Unit& u, int wr, int wc, int fr, int fq) const {
        asm volatile("" : "+v"(fr), "+v"(fq));
        const int row0 = mapA.src(u.pm) * 256 + wr * 64 + fr, col0 = u.pn * 256 + wc * 32 + 8 * fq;
        const int hd = u.pn >> 1;
        f32x4 gw[2][2]; f32x2 st[2][4];
#pragma unroll
        for (int bj = 0; bj < 2; ++bj) { gw[bj][0] = *(const f32x4*)(gnw + col0 + bj * 128); gw[bj][1] = *(const f32x4*)(gnw + col0 + bj * 128 + 4); }
#pragma unroll
        for (int ai = 0; ai < 2; ++ai)
#pragma unroll
            for (int m = 0; m < 4; ++m) st[ai][m] = ST[(size_t)(row0 + ai * 128 + m * 16) * 4 + hd];
#pragma unroll
        for (int ai = 0; ai < 2; ++ai) {
            u32x4 yv[4][2];
#pragma unroll
            for (int m = 0; m < 4; ++m)
#pragma unroll
                for (int bj = 0; bj < 2; ++bj) yv[m][bj] = *(const u32x4*)(Y + (size_t)(row0 + ai * 128 + m * 16) * 2048 + col0 + bj * 128);
            __builtin_amdgcn_sched_barrier(0);
#pragma unroll
            for (int m = 0; m < 4; ++m) { bf16_t* rowp = A2 + (size_t)(row0 + ai * 128 + m * 16) * 2048 + col0;
                const float mu = st[ai][m][0], rs = st[ai][m][1];
#pragma unroll
                for (int bj = 0; bj < 2; ++bj) { const f32x4 v0 = acc[ai][bj][m][0], v1 = acc[ai][bj][m][1]; const u32x4 yw = yv[m][bj];
                    const f32x4 y0 = (f32x4){bf_lo(yw.x), bf_hi(yw.x), bf_lo(yw.y), bf_hi(yw.y)}, y1 = (f32x4){bf_lo(yw.z), bf_hi(yw.z), bf_lo(yw.w), bf_hi(yw.w)};
                    const f32x4 n0 = (y0 - mu) * rs * gw[bj][0], n1 = (y1 - mu) * rs * gw[bj][1];
                    const f32x4 s0 = silu4(v0) * n0, s1 = silu4(v1) * n1;
                    u32x4 w; w.x = cvt_pk_bf16(s0[0], s0[1]); w.y = cvt_pk_bf16(s0[2], s0[3]); w.z = cvt_pk_bf16(s1[0], s1[1]); w.w = cvt_pk_bf16(s1[2], s1[3]);
                    *(u32x4*)(rowp + bj * 128) = w; } }
            __builtin_amdgcn_sched_barrier(0);
        }
    }
};

struct EpiSwiglu {
    static constexpr bool PERM = true;
    bf16_t* U; TileMap mapA;
    __device__ __forceinline__ void operator()(const AccT& acc, const Unit& u, int wr, int wc, int fr, int fq) const {
        asm volatile("" : "+v"(fr), "+v"(fq));
        const int gpm = mapA.src(u.pm);
        const int row0 = gpm * 256 + wr * 64 + fr, col0 = u.pn * 128 + wc * 32 + 8 * fq;
#pragma unroll
        for (int ai = 0; ai < 2; ++ai)
#pragma unroll
            for (int m = 0; m < 4; ++m) { bf16_t* rowp = U + (size_t)(row0 + ai * 128 + m * 16) * HID + col0;
                const f32x4 s0 = silu4(acc[ai][0][m][0]) * acc[ai][1][m][0], s1 = silu4(acc[ai][0][m][1]) * acc[ai][1][m][1];
                u32x4 w; w.x = cvt_pk_bf16(s0[0], s0[1]); w.y = cvt_pk_bf16(s0[2], s0[3]); w.z = cvt_pk_bf16(s1[0], s1[1]); w.w = cvt_pk_bf16(s1[2], s1[3]);
                *(u32x4*)rowp = w; }
    }
};

__device__ void norm_phase(const float* Xc, const float* Xl, bf16_t* H, const float* nw, const float* modl, int shi, int sci, int r0, int r1) {
    const int tid_ = opaque_tid(); const int wid = tid_ >> 6, lane = tid_ & 63;
    for (int row = r0 + (blockIdx.x * 8 + wid) * 4; row < r1; row += gridDim.x * 32) {
        const float* xp = (row < TCTX ? Xc : Xl) + (size_t)row * 1024 + lane * 4;
        f32x4 v[4][4]; float ss[4];
#pragma unroll
        for (int u = 0; u < 4; ++u)
#pragma unroll
            for (int q = 0; q < 4; ++q) v[u][q] = *(const f32x4*)(xp + u * 1024 + q * 256);
#pragma unroll
        for (int u = 0; u < 4; ++u) { float a = 0.f;
#pragma unroll
            for (int q = 0; q < 4; ++q) a += v[u][q][0] * v[u][q][0] + v[u][q][1] * v[u][q][1] + v[u][q][2] * v[u][q][2] + v[u][q][3] * v[u][q][3];
            ss[u] = a; }
#pragma unroll
        for (int o = 32; o >= 1; o >>= 1)
#pragma unroll
            for (int u = 0; u < 4; ++u) ss[u] += __int_as_float(__builtin_amdgcn_ds_bpermute((lane ^ o) << 2, __float_as_int(ss[u])));
        const int mb = row < TCTX ? 32 : (row - TCTX) >> 11;
        const float* shp = modl + ((size_t)mb * 6 + shi) * 1024; const float* scp = modl + ((size_t)mb * 6 + sci) * 1024;
#pragma unroll
        for (int q = 0; q < 4; ++q) { const int c = q * 256 + lane * 4;
            const f32x4 w = *(const f32x4*)(nw + c), sh = *(const f32x4*)(shp + c), sc = *(const f32x4*)(scp + c);
            const f32x4 wm = w * (sc + 1.0f);
#pragma unroll
            for (int u = 0; u < 4; ++u) { const float rstd = rsqrtf(ss[u] * (1.0f / 1024.0f) + 1e-6f);
                const f32x4 h = (v[u][q] * rstd) * wm + sh;
                u32x2 o; o.x = cvt_pk_bf16(h[0], h[1]); o.y = cvt_pk_bf16(h[2], h[3]);
                *(u32x2*)(H + (size_t)(row + u) * 1024 + c) = o; } }
    }
}

__device__ void final_norm_phase(const float* X, float* out, const float* nw) {
    const int tid_ = opaque_tid(); const int wid = tid_ >> 6, lane = tid_ & 63;
    for (int row = TCTX + (blockIdx.x * 8 + wid) * 4; row < TT; row += gridDim.x * 32) {
        const float* xp = X + (size_t)row * 1024 + lane * 4;
        f32x4 v[4][4]; float ss[4];
#pragma unroll
        for (int u = 0; u < 4; ++u)
#pragma unroll
            for (int q = 0; q < 4; ++q) v[u][q] = *(const f32x4*)(xp + u * 1024 + q * 256);
#pragma unroll
        for (int u = 0; u < 4; ++u) { float a = 0.f;
#pragma unroll
            for (int q = 0; q < 4; ++q) a += v[u][q][0] * v[u][q][0] + v[u][q][1] * v[u][q][1] + v[u][q][2] * v[u][q][2] + v[u][q][3] * v[u][q][3];
            ss[u] = a; }
#pragma unroll
        for (int o = 32; o >= 1; o >>= 1)
#pragma unroll
            for (int u = 0; u < 4; ++u) ss[u] += __int_as_float(__builtin_amdgcn_ds_bpermute((lane ^ o) << 2, __float_as_int(ss[u])));
#pragma unroll
        for (int q = 0; q < 4; ++q) { const int c = q * 256 + lane * 4; const f32x4 w = *(const f32x4*)(nw + c);
#pragma unroll
            for (int u = 0; u < 4; ++u) { const float rstd = rsqrtf(ss[u] * (1.0f / 1024.0f) + 1e-6f);
                *(f32x4*)(out + (size_t)(row + u - TCTX) * 1024 + c) = (v[u][q] * rstd) * w; } }
    }
}

template <int HW>
__device__ __forceinline__ void pool_item(const bf16_t* H, bf16_t* Dd, int row, int c) {
    int sb, L, t;
    if (row < TCTX) { sb = row & ~255; L = 256; t = row & 255; } else { sb = TCTX + ((row - TCTX) & ~2047); L = 2048; t = (row - TCTX) & 2047; }
    u32x4 wv[2 * HW];
#pragma unroll
    for (int k = 0; k < 2 * HW; ++k) { const int uu = t - HW + k; const bool ok = uu >= 0 && uu < L;
        wv[k] = ok ? *(const u32x4*)(H + (size_t)(sb + uu) * 1024 + c) : (u32x4){0u, 0u, 0u, 0u}; }
    float s[8];
#pragma unroll
    for (int j = 0; j < 8; ++j) s[j] = 0.f;
#pragma unroll
    for (int k = 0; k < 2 * HW; ++k) { const u32x4 w = wv[k];
        s[0] += bf_lo(w.x); s[1] += bf_hi(w.x); s[2] += bf_lo(w.y); s[3] += bf_hi(w.y); s[4] += bf_lo(w.z); s[5] += bf_hi(w.z); s[6] += bf_lo(w.w); s[7] += bf_hi(w.w); }
    const int lo = max(t - HW, 0), hi = min(t + HW, L);
    const float inv = 1.0f / (float)(hi - lo);
    const u32x4 w = wv[HW];
    u32x4 o;
    o.x = cvt_pk_bf16(s[0] * inv - bf_lo(w.x), s[1] * inv - bf_hi(w.x)); o.y = cvt_pk_bf16(s[2] * inv - bf_lo(w.y), s[3] * inv - bf_hi(w.y));
    o.z = cvt_pk_bf16(s[4] * inv - bf_lo(w.z), s[5] * inv - bf_hi(w.z)); o.w = cvt_pk_bf16(s[6] * inv - bf_lo(w.w), s[7] * inv - bf_hi(w.w));
    *(u32x4*)(Dd + (size_t)row * 1024 + c) = o;
}
__device__ void pool_phase(const bf16_t* H, bf16_t* Dd, int r0, int r1) {
    const int tid_ = opaque_tid(); const int wid = tid_ >> 6, lane = tid_ & 63;
    const int nw = (r1 - r0) * 2;
    for (int it = blockIdx.x * 8 + wid; it < nw; it += gridDim.x * 8) {
        const int gi = it & 3, row = r0 + (it >> 2) * 2 + (lane >> 5), c = gi * 256 + (lane & 31) * 8;
        if (gi == 0) pool_item<1>(H, Dd, row, c); else if (gi == 1) pool_item<2>(H, Dd, row, c); else if (gi == 2) pool_item<4>(H, Dd, row, c); else pool_item<8>(H, Dd, row, c);
    }
}

__device__ void stats_phase(const bf16_t* Y, f32x2* ST, int r0) {
    const int tid_ = opaque_tid(); const int wid = tid_ >> 6, lane = tid_ & 63;
    for (int row = r0 + (blockIdx.x * 8 + wid) * 2; row < TT; row += gridDim.x * 16) {
        const size_t off = (size_t)row * 2048 + lane * 8;
        u32x4 yw[8];
#pragma unroll
        for (int hh = 0; hh < 8; ++hh) yw[hh] = *(const u32x4*)(Y + off + hh * 512);
        float y[8][8], sm[8], vq[8];
#pragma unroll
        for (int hh = 0; hh < 8; ++hh) { y[hh][0] = bf_lo(yw[hh].x); y[hh][1] = bf_hi(yw[hh].x); y[hh][2] = bf_lo(yw[hh].y); y[hh][3] = bf_hi(yw[hh].y); y[hh][4] = bf_lo(yw[hh].z); y[hh][5] = bf_hi(yw[hh].z); y[hh][6] = bf_lo(yw[hh].w); y[hh][7] = bf_hi(yw[hh].w);
            float a = 0.f;
#pragma unroll
            for (int j = 0; j < 8; ++j) a += y[hh][j];
            sm[hh] = a; }
#pragma unroll
        for (int o = 32; o >= 1; o >>= 1)
#pragma unroll
            for (int hh = 0; hh < 8; ++hh) sm[hh] += __int_as_float(__builtin_amdgcn_ds_bpermute((lane ^ o) << 2, __float_as_int(sm[hh])));
#pragma unroll
        for (int hh = 0; hh < 8; ++hh) { const float mu = sm[hh] * (1.0f / 512.0f); float a = 0.f; sm[hh] = mu;
#pragma unroll
            for (int j = 0; j < 8; ++j) { const float d = y[hh][j] - mu; a += d * d; }
            vq[hh] = a; }
#pragma unroll
        for (int o = 32; o >= 1; o >>= 1)
#pragma unroll
            for (int hh = 0; hh < 8; ++hh) vq[hh] += __int_as_float(__builtin_amdgcn_ds_bpermute((lane ^ o) << 2, __float_as_int(vq[hh])));
        if (lane < 8) { float mu = sm[0], v = vq[0];
#pragma unroll
            for (int hh = 1; hh < 8; ++hh) { mu = lane == hh ? sm[hh] : mu; v = lane == hh ? vq[hh] : v; }
            ST[(size_t)row * 4 + lane] = (f32x2){mu, rsqrtf(v * (1.0f / 512.0f) + 1e-5f)}; }
    }
}

__device__ __forceinline__ int perm_qk(int c) { const int hh = c >> 8, hf = (c >> 7) & 1, dd = c & 127; return hh * 256 + hf * 128 + (dd & 1) * 64 + (dd >> 1); }

struct ConvD { const float* src; bf16_t* dst; int srcN, K, n0, k0, maptype; };
__device__ __forceinline__ ConvD conv_desc(const Params& p, bf16_t* Wb, int it) {
    int i = it;
    if (i < 1536) { const int j = i / 768, r = i % 768; return ConvD{p.ret_w_in + (size_t)j * 1024 * 6144, Wb + W_RETIN + (size_t)j * 6144 * 1024, 6144, 1024, (r / 8) * 64, (r % 8) * 128, 1}; }
    i -= 1536;
    if (i < 512) { const int j = i / 256, r = i % 256; return ConvD{p.ret_w_out + (size_t)j * 2048 * 1024, Wb + W_RETOUT + (size_t)j * 1024 * 2048, 1024, 2048, (r / 16) * 64, (r % 16) * 128, 0}; }
    i -= 512;
    if (i < 64) { const int jg = i / 8, r = i % 8; return ConvD{p.pool_w + (size_t)jg * 65536, Wb + W_POOL + (size_t)jg * 65536, 256, 256, (r / 2) * 64, (r % 2) * 128, 0}; }
    i -= 64;
    if (i < 2816) { const int l = i / 704, r = i % 704; return ConvD{p.ffn_w_in + (size_t)l * 1024 * 5632, Wb + W_FFNIN + (size_t)l * 5632 * 1024, 5632, 1024, (r / 8) * 64, (r % 8) * 128, 2}; }
    i -= 2816;
    { const int l = i / 352, r = i % 352; return ConvD{p.ffn_w_out + (size_t)l * HID * 1024, Wb + W_FFNOUT + (size_t)l * 1024 * HID, 1024, HID, (r / 22) * 64, (r % 22) * 128, 0}; }
}
__device__ __forceinline__ void conv_load(const ConvD& d, int tid, float (&v)[16]) {
    const int kk = tid >> 6, np = d.n0 + (tid & 63);
    int sc;
    if (d.maptype == 0) sc = np;
    else if (d.maptype == 1) sc = np < 2048 ? 4096 + np : (np < 3072 ? perm_qk(np - 2048) : (np < 4096 ? 1024 + perm_qk(np - 3072) : 2048 + (np - 4096)));
    else sc = ((np >> 7) & 1) * HID + (np >> 8) * 128 + (np & 127);
#pragma unroll
    for (int ps = 0; ps < 16; ++ps) v[ps] = d.src[(size_t)(d.k0 + kk + 8 * ps) * d.srcN + sc];
}
__device__ __forceinline__ void conv_finish(const ConvD& d, int tid, const float (&v)[16], float* lds) {
    { const int kk = tid >> 6, nn = tid & 63;
#pragma unroll
      for (int ps = 0; ps < 16; ++ps) lds[(kk + 8 * ps) * 65 + nn] = v[ps]; }
    __syncthreads();
    { const int nn = tid >> 3, kc = tid & 7;
#pragma unroll
      for (int hh = 0; hh < 2; ++hh) {
        float t[8];
#pragma unroll
        for (int e = 0; e < 8; ++e) t[e] = lds[(64 * hh + 8 * kc + e) * 65 + nn];
        u32x4 w; w.x = cvt_pk_bf16(t[0], t[1]); w.y = cvt_pk_bf16(t[2], t[3]); w.z = cvt_pk_bf16(t[4], t[5]); w.w = cvt_pk_bf16(t[6], t[7]);
        *(u32x4*)(d.dst + (size_t)(d.n0 + nn) * d.K + d.k0 + 64 * hh + 8 * kc) = w; } }
    __syncthreads();
}

__device__ void phase0(const Params& p, float* lds) {
    const int tid = opaque_tid(), wid = tid >> 6, lane = tid & 63;
    float* X = (float*)(p.ws + WS_X);
    bf16_t* Wb = (bf16_t*)((unsigned char*)p.out + OB_W);
    float* MOD = (float*)((unsigned char*)p.out + OB_MOD);
    f32x2* CS = (f32x2*)((unsigned char*)p.out + OB_CS);
    for (int idx = blockIdx.x * 512 + tid; idx < 4096; idx += gridDim.x * 512) {
        const int pos = idx >> 6, pp = idx & 63;
        const float inv = powf(10000.0f, -(float)(2 * pp) / 128.0f);
        const float angf = (float)pos * inv;
        double a = (double)angf;
        const double k = rint(a * 0.6366197723675814);
        const double rr = (a - k * 1.5707963267948966) - k * 6.123233995736766e-17;
        const int qd = ((int)k) & 3;
        const double r2 = rr * rr;
        double sn = rr * (1.0 + r2 * (-1.0 / 6 + r2 * (1.0 / 120 + r2 * (-1.0 / 5040 + r2 * (1.0 / 362880 + r2 * (-1.0 / 39916800 + r2 * (1.0 / 6227020800.0)))))));
        double cn = 1.0 + r2 * (-0.5 + r2 * (1.0 / 24 + r2 * (-1.0 / 720 + r2 * (1.0 / 40320 + r2 * (-1.0 / 3628800 + r2 * (1.0 / 479001600.0 + r2 * (-1.0 / 87178291200.0)))))));
        double cs_, sn_;
        if (qd == 0) { cs_ = cn; sn_ = sn; } else if (qd == 1) { cs_ = -sn; sn_ = cn; } else if (qd == 2) { cs_ = -cn; sn_ = -sn; } else { cs_ = sn; sn_ = -cn; }
        CS[idx] = (f32x2){(float)cs_, (float)sn_};
    }
    for (int it = blockIdx.x; it < 4 * 96; it += gridDim.x) {
        const int layer = it / 96, cb = it % 96;
        for (int idx = tid; idx < 33 * 1024; idx += 512) { const int r = idx >> 10, k = idx & 1023; const float v = r < 32 ? p.c[r * 1024 + k] : p.c_ctx[k]; lds[idx] = silu_f(v); }
        __syncthreads();
        const float* wp = p.ada_w + (size_t)layer * 1024 * 6144 + cb * 64 + lane;
        float acc[33];
#pragma unroll
        for (int r = 0; r < 33; ++r) acc[r] = 0.f;
        for (int k = wid * 128; k < wid * 128 + 128; k += 4) {
            const float w0 = wp[(size_t)k * 6144], w1 = wp[(size_t)(k + 1) * 6144], w2 = wp[(size_t)(k + 2) * 6144], w3 = wp[(size_t)(k + 3) * 6144];
#pragma unroll
            for (int r = 0; r < 33; ++r) { const f32x4 s4 = *(const f32x4*)(lds + r * 1024 + k); acc[r] += s4[0] * w0 + s4[1] * w1 + s4[2] * w2 + s4[3] * w3; }
        }
        __syncthreads();
#pragma unroll
        for (int r = 0; r < 33; ++r) lds[(wid * 33 + r) * 64 + lane] = acc[r];
        __syncthreads();
        for (int idx = tid; idx < 33 * 64; idx += 512) { const int r = idx >> 6, l = idx & 63; float sm = 0.f;
#pragma unroll
            for (int w = 0; w < 8; ++w) sm += lds[(w * 33 + r) * 64 + l];
            MOD[((size_t)layer * 33 + r) * 6144 + cb * 64 + l] = sm + p.ada_b[layer * 6144 + cb * 64 + l]; }
        __syncthreads();
    }
    {
        int it = blockIdx.x;
        if (it < 6336) {
            ConvD cur = conv_desc(p, Wb, it);
            float va[16];
            conv_load(cur, tid, va);
            for (;;) {
                const int nx = it + (int)gridDim.x; const bool has = nx < 6336;
                ConvD nd = cur; float vb[16];
#pragma unroll
                for (int q = 0; q < 16; ++q) vb[q] = 0.f;
                if (has) { nd = conv_desc(p, Wb, nx); conv_load(nd, tid, vb); }
                conv_finish(cur, tid, va, lds);
                if (!has) break;
                cur = nd; it = nx;
#pragma unroll
                for (int q = 0; q < 16; ++q) va[q] = vb[q];
            }
        }
    }
}

constexpr int QS_LD = 264, KS_LD = 272, P_LD = 80, QP_LD = 272;
template <int ST>
__device__ __forceinline__ void kt_issue(unsigned addr, u32x2 (&o)[8]) {
    constexpr int RB = KS_LD * 2;
    asm volatile(
        "ds_read_b64_tr_b16 %0, %8 offset:%9\n\t"
        "ds_read_b64_tr_b16 %1, %8 offset:%10\n\t"
        "ds_read_b64_tr_b16 %2, %8 offset:%11\n\t"
        "ds_read_b64_tr_b16 %3, %8 offset:%12\n\t"
        "ds_read_b64_tr_b16 %4, %8 offset:%13\n\t"
        "ds_read_b64_tr_b16 %5, %8 offset:%14\n\t"
        "ds_read_b64_tr_b16 %6, %8 offset:%15\n\t"
        "ds_read_b64_tr_b16 %7, %8 offset:%16"
        : "=&v"(o[0]), "=&v"(o[1]), "=&v"(o[2]), "=&v"(o[3]), "=&v"(o[4]), "=&v"(o[5]), "=&v"(o[6]), "=&v"(o[7])
        : "v"(addr),
          "n"((0 * 32 + 0) * RB + 32 * (2 * ST)), "n"((0 * 32 + 4) * RB + 32 * (2 * ST)),
          "n"((1 * 32 + 0) * RB + 32 * (2 * ST)), "n"((1 * 32 + 4) * RB + 32 * (2 * ST)),
          "n"((0 * 32 + 0) * RB + 32 * (2 * ST + 1)), "n"((0 * 32 + 4) * RB + 32 * (2 * ST + 1)),
          "n"((1 * 32 + 0) * RB + 32 * (2 * ST + 1)), "n"((1 * 32 + 4) * RB + 32 * (2 * ST + 1))
        : "memory");
}
template <int N>
__device__ __forceinline__ void kt_wait(u32x2 (&o)[8]) {
    asm volatile("s_waitcnt lgkmcnt(%8)" : "+v"(o[0]), "+v"(o[1]), "+v"(o[2]), "+v"(o[3]), "+v"(o[4]), "+v"(o[5]), "+v"(o[6]), "+v"(o[7]) : "n"(N) : "memory");
}
constexpr int VS_LD = 136;
__device__ __forceinline__ void vt_issue(unsigned addr, u32x2 (&o)[4]) {
    constexpr int RB = VS_LD * 2;
    asm volatile(
        "ds_read_b64_tr_b16 %0, %4 offset:%5\n\t"
        "ds_read_b64_tr_b16 %1, %4 offset:%6\n\t"
        "ds_read_b64_tr_b16 %2, %4 offset:%7\n\t"
        "ds_read_b64_tr_b16 %3, %4 offset:%8"
        : "=&v"(o[0]), "=&v"(o[1]), "=&v"(o[2]), "=&v"(o[3])
        : "v"(addr), "n"(0 * RB), "n"(4 * RB), "n"(32 * RB), "n"(36 * RB)
        : "memory");
}
__device__ __forceinline__ void vt_wait(u32x2 (&o)[4]) {
    asm volatile("s_waitcnt lgkmcnt(0)" : "+v"(o[0]), "+v"(o[1]), "+v"(o[2]), "+v"(o[3]) : : "memory");
}
__device__ __forceinline__ bf16x8 kt_frag(const u32x2& a, const u32x2& b) { return __builtin_bit_cast(bf16x8, (u32x4){a.x, a.y, b.x, b.y}); }
template <int ST, bool LAST>
__device__ __forceinline__ void kt_step(unsigned addr, u32x2 (&cur)[8], u32x2 (&nxt)[8], f32x4 (&S)[16], const bf16x8 (&Vs)[2], float Gc) {
    if constexpr (!LAST) kt_issue<ST + 1>(addr, nxt);
    kt_wait<LAST ? 0 : 8>(cur);
    constexpr int m0 = 2 * ST, m1 = 2 * ST + 1;
    S[m0] = S[m0] * Gc; S[m1] = S[m1] * Gc;
    S[m0] = __builtin_amdgcn_mfma_f32_16x16x32_bf16(kt_frag(cur[0], cur[1]), Vs[0], S[m0], 0, 0, 0);
    S[m1] = __builtin_amdgcn_mfma_f32_16x16x32_bf16(kt_frag(cur[4], cur[5]), Vs[0], S[m1], 0, 0, 0);
    S[m0] = __builtin_amdgcn_mfma_f32_16x16x32_bf16(kt_frag(cur[2], cur[3]), Vs[1], S[m0], 0, 0, 0);
    S[m1] = __builtin_amdgcn_mfma_f32_16x16x32_bf16(kt_frag(cur[6], cur[7]), Vs[1], S[m1], 0, 0, 0);
}
template <bool WITH_B>
__device__ __forceinline__ void scan_bc(const bf16_t* Ps, const bf16_t* Qp, int r, int g, const bf16x8 (&Vf)[2], const f32x4 (&S)[16], f32x4 (&o1)[4], f32x4 (&o2)[4]) {
    constexpr int S0 = WITH_B ? 0 : 2;
    u32x4 fb[2][4];
    const bf16_t* pp = Ps + r * P_LD + 8 * g;
    const bf16_t* qp = Qp + r * QP_LD + 8 * g;
    if constexpr (WITH_B) {
#pragma unroll
        for (int nt = 0; nt < 4; ++nt) fb[0][nt] = *(const u32x4*)(pp + 16 * nt * P_LD);
    } else {
#pragma unroll
        for (int nt = 0; nt < 4; ++nt) fb[0][nt] = *(const u32x4*)(qp + 16 * nt * QP_LD);
    }
#pragma unroll
    for (int st = S0; st < 10; ++st) {
        const int nx = st + 1;
        if (nx < 2) {
#pragma unroll
            for (int nt = 0; nt < 4; ++nt) fb[nx & 1][nt] = *(const u32x4*)(pp + 16 * nt * P_LD + 32 * nx);
        } else if (nx < 10) {
#pragma unroll
            for (int nt = 0; nt < 4; ++nt) fb[nx & 1][nt] = *(const u32x4*)(qp + 16 * nt * QP_LD + 32 * (nx - 2));
        }
        if (st < 2) {
#pragma unroll
            for (int nt = 0; nt < 4; ++nt) o1[nt] = __builtin_amdgcn_mfma_f32_16x16x32_bf16(Vf[st], __builtin_bit_cast(bf16x8, fb[st & 1][nt]), o1[nt], 0, 0, 0);
        } else {
            const int T = st - 2;
            u32x4 aw; aw.x = cvt_pk_bf16(S[2 * T][0], S[2 * T][1]); aw.y = cvt_pk_bf16(S[2 * T][2], S[2 * T][3]); aw.z = cvt_pk_bf16(S[2 * T + 1][0], S[2 * T + 1][1]); aw.w = cvt_pk_bf16(S[2 * T + 1][2], S[2 * T + 1][3]);
            const bf16x8 a = __builtin_bit_cast(bf16x8, aw);
#pragma unroll
            for (int nt = 0; nt < 4; ++nt) o2[nt] = __builtin_amdgcn_mfma_f32_16x16x32_bf16(a, __builtin_bit_cast(bf16x8, fb[st & 1][nt]), o2[nt], 0, 0, 0);
        }
        __builtin_amdgcn_sched_barrier(0);
    }
}

__device__ void ret_phase(const Params& p, unsigned char* ldsb, int lj, int half) {
    const int tid0 = opaque_tid(), w = __builtin_amdgcn_readfirstlane(tid0 >> 6), lane0 = tid0 & 63, r0_ = lane0 & 15, g0_ = lane0 >> 4;
    bf16_t* Qs = (bf16_t*)ldsb;
    bf16_t* Ks = Qs + 64 * QS_LD;
    bf16_t* Ps = Ks + 64 * KS_LD;
    bf16_t* Vl = Ps + 64 * P_LD;
    bf16_t* Qp = Vl + 64 * VS_LD;
    const bf16_t* Qg = (const bf16_t*)(p.ws + WS_R1);
    const bf16_t* Kg = Qg + (size_t)TH * 1024;
    const bf16_t* Vg = Kg + (size_t)TH * 1024;
    bf16_t* Y = (bf16_t*)(p.ws + WS_Y);
    const int jb = w & 3, ih = w >> 2;
    for (int item = blockIdx.x; item < 256; item += gridDim.x) {
        const int xq = item & 7, yq = item >> 3, sl = yq & 3, bh = (yq >> 2) * 8 + xq, bl = bh >> 2, h = bh & 3;
        const int bglob = half * 16 + bl;
        const float l2gF = -fabsf(p.ret_log_decay[(lj * 2 + 0) * 4 + h]) * 1.4426950408889634f, l2gB = -fabsf(p.ret_log_decay[(lj * 2 + 1) * 4 + h]) * 1.4426950408889634f;
        for (int pass = 0; pass < 2; ++pass) {
            const int dir = 1 - pass;
            const float lg = -fabsf(p.ret_log_decay[(lj * 2 + dir) * 4 + h]);
            const float l2g = lg * 1.4426950408889634f;
            const float Gc = __builtin_amdgcn_exp2f(64.0f * l2g);
            float ge[8];
#pragma unroll
            for (int e = 0; e < 8; ++e) ge[e] = __builtin_amdgcn_exp2f((dir == 0 ? -(float)e : (float)e) * l2g);
            f32x4 S[16];
#pragma unroll
            for (int i = 0; i < 16; ++i) S[i] = (f32x4){0.f, 0.f, 0.f, 0.f};
            u32x4 sq[4], sk[4]; u32x4 sv[2]; u32x2 yold[4];
            auto spos = [&](int c) -> int { return dir == 0 ? 64 * c : (c < 4 ? 192 - 64 * c : 2496 - 64 * c); };
            auto lrow = [&](int s0) -> int { return s0 < 256 ? bl * 256 + s0 : 4096 + bl * 2048 + (s0 - 256); };
            auto grow = [&](int s0) -> int { return s0 < 256 ? bglob * 256 + s0 : TCTX + bglob * 2048 + (s0 - 256); };
            const unsigned vo_qk = (unsigned)(((tid0 >> 5) * 1024 + (tid0 & 31) * 8) * 2);
            const unsigned vo_v = (unsigned)(((tid0 >> 4) * 2048 + (tid0 & 15) * 8) * 2);
            const unsigned vo_y = (unsigned)((r0_ * 2048 + 4 * g0_) * 2);
            auto issueQ = [&](int c) { const char* bq = (const char*)(Qg + (size_t)lrow(spos(c)) * 1024 + h * 256);
#pragma unroll
                for (int k = 0; k < 4; ++k) sq[k] = *(const u32x4*)(bq + (size_t)k * 32768 + vo_qk); };
            auto issueK = [&](int c) { const char* bk = (const char*)(Kg + (size_t)lrow(spos(c)) * 1024 + h * 256);
#pragma unroll
                for (int k = 0; k < 4; ++k) sk[k] = *(const u32x4*)(bk + (size_t)k * 32768 + vo_qk); };
            auto issueVY = [&](int c) { const char* bv = (const char*)(Vg + (size_t)lrow(spos(c)) * 2048 + h * 512 + sl * 128);
#pragma unroll
                for (int k = 0; k < 2; ++k) sv[k] = *(const u32x4*)(bv + (size_t)k * 131072 + vo_v);
                if (pass == 1) { const char* by = (const char*)(Y + (size_t)grow(spos(c)) * 2048 + h * 512 + sl * 128 + 16 * w);
#pragma unroll
                    for (int nt = 0; nt < 4; ++nt) yold[nt] = *(const u32x2*)(by + (size_t)nt * 65536 + vo_y); } };
            issueQ(0); issueK(0); issueVY(0);
            for (int c = 0; c < 36; ++c) {
                const int s0 = spos(c);
                int tid = tid0, r = r0_, g = g0_; asm volatile("" : "+v"(tid), "+v"(r), "+v"(g));
                const int grow0 = grow(s0);
#pragma unroll
                for (int k = 0; k < 4; ++k) { const int ch = tid + 512 * k, ri = ch >> 5, cc = ch & 31;
                    if (pass == 0) *(u32x4*)(Qs + ri * QS_LD + cc * 8) = sq[k];
                    bf16_t* qd_ = Qp + ri * QP_LD + 32 * (cc >> 2) + 16 * (cc & 1) + 4 * ((cc >> 1) & 1);
                    *(u32x2*)qd_ = (u32x2){sq[k].x, sq[k].y}; *(u32x2*)(qd_ + 8) = (u32x2){sq[k].z, sq[k].w};
                    *(u32x4*)(Ks + ri * KS_LD + cc * 8) = sk[k]; }
#pragma unroll
                for (int k = 0; k < 2; ++k) { const int ch = tid + 512 * k, ri = ch >> 4, cc = ch & 15; *(u32x4*)(Vl + ri * VS_LD + cc * 8) = sv[k]; }
                u32x2 yo[4];
#pragma unroll
                for (int nt = 0; nt < 4; ++nt) yo[nt] = yold[nt];
                __syncthreads();
                u32x2 vv[4];
                vt_issue((unsigned)(size_t)Vl + (unsigned)(((8 * g + (r >> 2)) * VS_LD + 16 * w + 4 * (r & 3)) * 2), vv);
                if (c + 1 < 36) issueQ(c + 1);
                vt_wait(vv);
                bf16x8 Vf[2], Vs[2];
#pragma unroll
                for (int t = 0; t < 2; ++t) {
                    const u32x4 vft = (u32x4){vv[2 * t].x, vv[2 * t].y, vv[2 * t + 1].x, vv[2 * t + 1].y};
                    Vf[t] = __builtin_bit_cast(bf16x8, vft);
                    const int j0 = 32 * t + 8 * g;
                    const float base = __builtin_amdgcn_exp2f((dir == 0 ? (float)(63 - j0) : (float)j0) * l2g);
                    const unsigned uu[4] = {vft.x, vft.y, vft.z, vft.w};
                    unsigned oo[4];
#pragma unroll
                    for (int e2 = 0; e2 < 4; ++e2) oo[e2] = cvt_pk_bf16(bf_lo(uu[e2]) * (base * ge[2 * e2]), bf_hi(uu[e2]) * (base * ge[2 * e2 + 1]));
                    Vs[t] = __builtin_bit_cast(bf16x8, (u32x4){oo[0], oo[1], oo[2], oo[3]});
                }
                const bool deadout = (lj == 1) && (s0 < 256);
                if (pass == 0 && !deadout) {
                    f32x4 sc[2] = {(f32x4){0.f, 0.f, 0.f, 0.f}, (f32x4){0.f, 0.f, 0.f, 0.f}};
                    const bf16_t* kp = Ks + (16 * jb + r) * KS_LD + 8 * g;
                    const bf16_t* qp0 = Qs + (32 * ih + r) * QS_LD + 8 * g;
                    bf16x8 ka[2], qb[2][2];
                    ka[0] = *(const bf16x8*)kp; qb[0][0] = *(const bf16x8*)qp0; qb[0][1] = *(const bf16x8*)(qp0 + 16 * QS_LD);
#pragma unroll
                    for (int t = 0; t < 8; ++t) {
                        if (t + 1 < 8) { ka[(t + 1) & 1] = *(const bf16x8*)(kp + 32 * (t + 1)); qb[(t + 1) & 1][0] = *(const bf16x8*)(qp0 + 32 * (t + 1)); qb[(t + 1) & 1][1] = *(const bf16x8*)(qp0 + 16 * QS_LD + 32 * (t + 1)); }
                        sc[0] = __builtin_amdgcn_mfma_f32_16x16x32_bf16(ka[t & 1], qb[t & 1][0], sc[0], 0, 0, 0);
                        sc[1] = __builtin_amdgcn_mfma_f32_16x16x32_bf16(ka[t & 1], qb[t & 1][1], sc[1], 0, 0, 0);
                        __builtin_amdgcn_sched_barrier(0);
                    }
#pragma unroll
                    for (int nt = 0; nt < 2; ++nt) { const int i = 32 * ih + 16 * nt + r; const int j0 = 16 * jb + 4 * g;
                        float pv[4];
#pragma unroll
                        for (int jj = 0; jj < 4; ++jj) { const int df = j0 + jj - i;
                            pv[jj] = sc[nt][jj] * __builtin_amdgcn_exp2f(df > 0 ? (float)df * l2gB : (float)(-df) * l2gF); }
                        u32x2 o; o.x = cvt_pk_bf16(pv[0], pv[1]); o.y = cvt_pk_bf16(pv[2], pv[3]);
                        *(u32x2*)(Ps + i * P_LD + j0) = o; }
                }
                if (c + 1 < 36) issueK(c + 1);
                f32x4 o1[4], o2[4];
#pragma unroll
                for (int nt = 0; nt < 4; ++nt) { o1[nt] = (f32x4){0.f, 0.f, 0.f, 0.f}; o2[nt] = (f32x4){0.f, 0.f, 0.f, 0.f}; }
                if (!deadout) {
                    if (pass == 0) { __syncthreads(); scan_bc<true>(Ps, Qp, r, g, Vf, S, o1, o2); }
                    else if (c > 0) scan_bc<false>(Ps, Qp, r, g, Vf, S, o1, o2);
                }
                if (c + 1 < 36) issueVY(c + 1);
                if (c < 35) {
                    u32x2 fa0[8], fa1[8];
                    const unsigned kaddr = (unsigned)(size_t)Ks + (unsigned)(((8 * g + (r >> 2)) * KS_LD + 4 * (r & 3)) * 2);
                    kt_issue<0>(kaddr, fa0);
                    kt_step<0, false>(kaddr, fa0, fa1, S, Vs, Gc);
                    kt_step<1, false>(kaddr, fa1, fa0, S, Vs, Gc);
                    kt_step<2, false>(kaddr, fa0, fa1, S, Vs, Gc);
                    kt_step<3, false>(kaddr, fa1, fa0, S, Vs, Gc);
                    kt_step<4, false>(kaddr, fa0, fa1, S, Vs, Gc);
                    kt_step<5, false>(kaddr, fa1, fa0, S, Vs, Gc);
                    kt_step<6, false>(kaddr, fa0, fa1, S, Vs, Gc);
                    kt_step<7, true>(kaddr, fa1, fa0, S, Vs, Gc);
                }
                if (!deadout)
#pragma unroll
                for (int nt = 0; nt < 4; ++nt) { const int i = 16 * nt + r;
                    const float qd = __builtin_amdgcn_exp2f((dir == 0 ? (float)(i + 1) : (float)(64 - i)) * l2g);
                    f32x4 yv = o1[nt] + o2[nt] * qd;
                    bf16_t* yp = (bf16_t*)((char*)(Y + (size_t)grow0 * 2048 + h * 512 + sl * 128 + 16 * w) + (size_t)nt * 65536 + vo_y);
                    if (pass == 1) { yv[0] += bf_lo(yo[nt].x); yv[1] += bf_hi(yo[nt].x); yv[2] += bf_lo(yo[nt].y); yv[3] += bf_hi(yo[nt].y); }
                    u32x2 o; o.x = cvt_pk_bf16(yv[0], yv[1]); o.y = cvt_pk_bf16(yv[2], yv[3]);
                    *(u32x2*)yp = o; }
                __syncthreads();
            }
        }
    }
}

__device__ __forceinline__ void gbar(unsigned* ctr, unsigned& target) {
    asm volatile("s_waitcnt vmcnt(0) lgkmcnt(0)" ::: "memory");
    __syncthreads();
    target += gridDim.x;
    if (threadIdx.x == 0) {
        __builtin_amdgcn_fence(__ATOMIC_RELEASE, "agent");
        asm volatile("s_waitcnt vmcnt(0)" ::: "memory");
        __hip_atomic_fetch_add(ctr, 1u, __ATOMIC_RELAXED, __HIP_MEMORY_SCOPE_AGENT);
        while (__hip_atomic_load(ctr, __ATOMIC_RELAXED, __HIP_MEMORY_SCOPE_AGENT) < target) __builtin_amdgcn_s_sleep(2);
        __builtin_amdgcn_fence(__ATOMIC_ACQUIRE, "agent");
        asm volatile("s_waitcnt vmcnt(0)" ::: "memory");
    }
    __syncthreads();
}

__global__ void __launch_bounds__(512, 2) mega(Params p) {
    extern __shared__ __attribute__((aligned(16))) unsigned char shm[];
    cg::grid_group grid = cg::this_grid();
    LAS unsigned char* lds = (LAS unsigned char*)shm;
    float* X = (float*)(p.ws + WS_X);
    unsigned char* R1 = p.ws + WS_R1;
    bf16_t* Y = (bf16_t*)(p.ws + WS_Y);
    bf16_t* H = (bf16_t*)((unsigned char*)p.out + OB_H);
    const bf16_t* Wb = (const bf16_t*)((unsigned char*)p.out + OB_W);
    const float* MOD = (const float*)((unsigned char*)p.out + OB_MOD);
    const f32x2* CS = (const f32x2*)((unsigned char*)p.out + OB_CS);
    const TileMap idm = {1 << 30, 0, 0};
    unsigned* bar = (unsigned*)(p.ws + WS_BAR); unsigned btarget = 0;

    phase0(p, (float*)shm);
    grid.sync();

    for (int layer = 0; layer < 4; ++layer) {
        const bool last = layer == 3;
        const bool use_ret = (layer & 1) == 0;
        const int lj = layer >> 1;
        const float* modl = MOD + (size_t)layer * 33 * 6144;
        const int r0 = last ? TCTX : 0;
        const TileMap rowmap = last ? TileMap{0, 0, 32} : idm;
        const int Mrows = last ? (TT - TCTX) : TT;
        const bool latpost = layer >= 2;
        const int r0p = latpost ? TCTX : 0;
        const TileMap rowmapp = latpost ? TileMap{0, 0, 32} : idm;
        const int Mrowsp = latpost ? (TT - TCTX) : TT;

        const float* Xc = layer == 0 ? p.ctx : X; const float* Xl = layer == 0 ? p.x - (size_t)TCTX * 1024 : X;
        norm_phase(Xc, Xl, H, p.norm1_w + layer * 1024, modl, 0, 1, r0, TT);
        gbar(bar, btarget);

        if (use_ret) {
            const bf16_t* Win = Wb + W_RETIN + (size_t)lj * 6144 * 1024;
            bf16_t* Qg = (bf16_t*)R1; bf16_t* Kg = Qg + (size_t)TH * 1024; bf16_t* VTg = Kg + (size_t)TH * 1024;
            for (int half = 0; half < 2; ++half) {
                const TileMap hm = {16, 16 * half, 32 + 128 * half};
                { Gemm g = {H, Win + (size_t)2048 * 1024, 1024, 1024, TH, 4096, 1024, hm, idm, 0};
                  EpiQK E = {Qg, Kg, VTg, CS, hm};
                  pg8::gemm_phase(lds, g, E); }
                gbar(bar, btarget);
                ret_phase(p, shm, lj, half);
                gbar(bar, btarget);
            }
            stats_phase(Y, (f32x2*)(p.ws + WS_ST), r0p);
            gbar(bar, btarget);
            { Gemm g = {H, Win, 1024, 1024, Mrowsp, 2048, 1024, rowmapp, idm, 0};
              EpiSiluGN E = {(bf16_t*)R1, rowmapp, Y, (const f32x2*)(p.ws + WS_ST), p.ret_gn_w + lj * 2048};
              pg8::gemm_phase(lds, g, E); }
            gbar(bar, btarget);
            { Gemm g = {(const bf16_t*)R1, Wb + W_RETOUT + (size_t)lj * 1024 * 2048, 2048, 2048, Mrowsp, 1024, 2048, rowmapp, idm, 0};
              EpiRes E = {X, Xc, Xl, modl, 2, nullptr, rowmapp};
              pg8::gemm_phase(lds, g, E); }
            gbar(bar, btarget);
        } else {
            pool_phase(H, (bf16_t*)R1, r0, TT);
            gbar(bar, btarget);
            { Gemm g = {(const bf16_t*)R1, Wb + W_POOL + (size_t)lj * 262144, 1024, 256, Mrows, 1024, 256, rowmap, idm, 512};
              EpiRes E = {X, X, X, modl, 2, p.pool_scale + lj * 1024, rowmap};
              pg8::gemm_phase(lds, g, E); }
            gbar(bar, btarget);
        }

        norm_phase(X, X, H, p.norm2_w + layer * 1024, modl, 3, 4, r0p, TT);
        gbar(bar, btarget);
        { Gemm g = {H, Wb + W_FFNIN + (size_t)layer * 5632 * 1024, 1024, 1024, Mrowsp, 5632, 1024, rowmapp, idm, 0};
          EpiSwiglu E = {(bf16_t*)R1, rowmapp};
          pg8::gemm_phase(lds, g, E); }
        gbar(bar, btarget);
        { Gemm g = {(const bf16_t*)R1, Wb + W_FFNOUT + (size_t)layer * 1024 * HID, HID, HID, Mrowsp, 1024, HID, rowmapp, idm, 0};
          EpiRes E = {X, X, X, modl, 5, nullptr, rowmapp};
          pg8::gemm_phase(lds, g, E); }
        gbar(bar, btarget);
    }
    final_norm_phase(X, p.out, p.final_norm_w);
}

extern "C" void kernel_launch(void* const* d_in, const int* in_sizes, int n_in, void* d_out, int out_size, void* d_ws, size_t ws_size, hipStream_t stream) {
    static int grid_blocks = 0;
    if (!grid_blocks) {
        if (ws_size < WS_END || n_in < 17) { fprintf(stderr, "kernel_launch: workspace too small (%zu < %zu) or n_in %d\n", ws_size, (size_t)WS_END, n_in); grid_blocks = -1; return; }
        int dev = 0, cus = 0, per_cu = 0;
        hipGetDevice(&dev);
        hipDeviceGetAttribute(&cus, hipDeviceAttributeMultiprocessorCount, dev);
        if (hipFuncSetAttribute((const void*)mega, hipFuncAttributeMaxDynamicSharedMemorySize, LDS_BYTES) != hipSuccess) { fprintf(stderr, "kernel_launch: hipFuncSetAttribute failed\n"); grid_blocks = -1; return; }
        hipOccupancyMaxActiveBlocksPerMultiprocessor(&per_cu, (const void*)mega, 512, LDS_BYTES);
        if (per_cu < 1) { fprintf(stderr, "kernel_launch: occupancy query returned %d\n", per_cu); per_cu = 1; }
        grid_blocks = cus * per_cu;
    }
    if (grid_blocks < 0) return;
    Params p{};
    p.x = (const float*)d_in[0]; p.c = (const float*)d_in[1]; p.ctx = (const float*)d_in[2]; p.c_ctx = (const float*)d_in[3];
    p.ada_w = (const float*)d_in[4]; p.ada_b = (const float*)d_in[5]; p.norm1_w = (const float*)d_in[6]; p.norm2_w = (const float*)d_in[7];
    p.ret_w_in = (const float*)d_in[8]; p.ret_log_decay = (const float*)d_in[9]; p.ret_gn_w = (const float*)d_in[10]; p.ret_w_out = (const float*)d_in[11];
    p.pool_w = (const float*)d_in[12]; p.pool_scale = (const float*)d_in[13]; p.ffn_w_in = (const float*)d_in[14]; p.ffn_w_out = (const float*)d_in[15];
    p.final_norm_w = (const float*)d_in[16];
    p.out = (float*)d_out; p.ws = (unsigned char*)d_ws;
    if (hipMemsetAsync((unsigned char*)d_ws + WS_BAR, 0, 256, stream) != hipSuccess) { fprintf(stderr, "kernel_launch: memset failed\n"); return; }
    void* args[] = {&p};
    hipError_t e = hipLaunchCooperativeKernel((const void*)mega, dim3(grid_blocks), dim3(512), args, LDS_BYTES, stream);
    if (e != hipSuccess) fprintf(stderr, "cooperative launch failed: %s (grid %d)\n", hipGetErrorString(e), grid_blocks);
}
```

```cpp
#include <hip/hip_runtime.h>
#include <hip/hip_cooperative_groups.h>
#include <cstdio>
namespace cg = cooperative_groups;

#define LAS __attribute__((address_space(3)))
typedef unsigned short bf16_t;
typedef short bf16x8 __attribute__((ext_vector_type(8)));
typedef float f32x4 __attribute__((ext_vector_type(4)));
typedef float f32x2 __attribute__((ext_vector_type(2)));
typedef unsigned u32x4 __attribute__((ext_vector_type(4)));
typedef unsigned u32x2 __attribute__((ext_vector_type(2)));

constexpr int DM = 1024, NB = 32, SEQ = 2048, CTXL = 256, HID = 2816;
constexpr int TCTX = NB * CTXL;
constexpr int TT = TCTX + NB * SEQ;
constexpr int TH = TT / 2;
constexpr int LDS_BYTES = 135168;

constexpr size_t WS_X = 0;
constexpr size_t WS_R1 = 301989888ull;
constexpr size_t WS_Y = WS_R1 + 377487360ull;
constexpr size_t WS_BAR = WS_Y + 301989888ull;
constexpr size_t WS_ST = WS_BAR + 256;
constexpr size_t WS_END = WS_ST + 2359296ull;
constexpr size_t OB_H = 0;
constexpr size_t OB_W = 150994944ull;
constexpr size_t OB_MOD = 254803968ull;
constexpr size_t OB_CS = 258048000ull;
constexpr size_t W_RETIN = 0, W_RETOUT = 12582912ull, W_POOL = 16777216ull, W_FFNIN = 17301504ull, W_FFNOUT = 40370176ull;

struct Params {
    const float *x, *c, *ctx, *c_ctx, *ada_w, *ada_b, *norm1_w, *norm2_w, *ret_w_in, *ret_log_decay, *ret_gn_w, *ret_w_out, *pool_w, *pool_scale, *ffn_w_in, *ffn_w_out, *final_norm_w;
    float* out; unsigned char* ws;
};

__device__ __forceinline__ unsigned cvt_pk_bf16(float lo, float hi) { unsigned r; asm("v_cvt_pk_bf16_f32 %0, %1, %2" : "=v"(r) : "v"(lo), "v"(hi)); return r; }
__device__ __forceinline__ float bf_lo(unsigned u) { return __uint_as_float(u << 16); }
__device__ __forceinline__ float bf_hi(unsigned u) { return __uint_as_float(u & 0xffff0000u); }
__device__ __forceinline__ int opaque_tid() { int t = threadIdx.x; asm volatile("" : "+v"(t)); return t; }
__device__ __forceinline__ float silu_f(float v) { return v * __builtin_amdgcn_rcpf(1.0f + __expf(-v)); }
__device__ __forceinline__ f32x4 silu4(f32x4 v) {
    f32x4 e, r;
#pragma unroll
    for (int j = 0; j < 4; ++j) e[j] = __builtin_amdgcn_exp2f(v[j] * -1.4426950408889634f);
#pragma unroll
    for (int j = 0; j < 4; ++j) r[j] = __builtin_amdgcn_rcpf(1.0f + e[j]);
    return v * r;
}

namespace pg8 {
constexpr int BM = 256, BK = 64, HALF = 128, HTB = HALF * BK * 2, STAGE_BYTES = 8 * HTB, NXCD = 8, WGM = 4;
__host__ __device__ __forceinline__ int lds_byte(int r, int c) { const int st = (r >> 4) * 2 + (c >> 5), rr = r & 15, cc = c & 31, ob = rr * 64 + cc * 2; return st * 1024 + (ob ^ (((ob >> 9) & 1) << 5)); }
__host__ __device__ __forceinline__ void stage_rc(int b, int& R, int& C) { const int st = b / 1024, sb = b % 1024, swz = sb ^ (((sb >> 9) & 1) << 5); R = (st >> 1) * 16 + swz / 64; C = (st & 1) * 32 + (swz % 64) / 2; }
__host__ __device__ __forceinline__ int perm32(int rho) { const int n = rho >> 4, i = rho & 15; return 8 * (i >> 2) + 4 * n + (i & 3); }

struct Unit { int pm, pn; };
struct TileMap { int nctx, ctx0, lat0; __device__ __forceinline__ int src(int t) const { return t < nctx ? ctx0 + t : lat0 + (t - nctx); } };
struct Gemm { const bf16_t* A; const bf16_t* Bt; int lda, ldb, M, N, K; TileMap mapA, mapB; int a_pn_step; };

struct StaticOrder {
    int nM, nN, nwg, G, c;
    __device__ void init(int M, int N, int G_, int c_) { nM = M / BM; nN = N / BM; nwg = nM * nN; G = G_; c = c_; }
    __device__ bool next(int i, Unit& u) const {
        const long L = (long)i * G + c; if (L >= nwg) return false;
        int wgid = (int)L; { const int q = nwg / NXCD, r = nwg % NXCD, xcd = wgid % NXCD, off = wgid / NXCD; wgid = (xcd < r ? xcd * (q + 1) : r * (q + 1) + (xcd - r) * q) + off; }
        const int nig = WGM * nN, gid = wgid / nig, fm = gid * WGM, gsz = (nM - fm) < WGM ? (nM - fm) : WGM;
        u.pm = fm + ((wgid % nig) % gsz); u.pn = (wgid % nig) / gsz; return true;
    }
};

template <class Epi>
__device__ __forceinline__ void gemm_phase(LAS unsigned char* lds, const Gemm g, const Epi& E) {
    const int tid = opaque_tid(), wid = __builtin_amdgcn_readfirstlane(tid >> 6), lane = tid & 63, wr = wid >> 2, wc = wid & 3, fr = lane & 15, fq = lane >> 4;
    const int K = g.K, nt = K / BK;
    StaticOrder S; S.init(g.M, g.N, (int)gridDim.x, (int)blockIdx.x);
    unsigned voffA[2], voffB[2];
#pragma unroll
    for (int i = 0; i < 2; ++i) { int R, C; stage_rc(tid * 16 + i * 8192, R, C); const int Rb = Epi::PERM ? ((R & ~31) + perm32(R & 31)) : R;
        voffA[i] = (unsigned)(R * g.lda + C) * 2u; voffB[i] = (unsigned)(Rb * g.ldb + C) * 2u; }
    const size_t kstep = (size_t)(BK * 2);
    const size_t hstepA = (size_t)HALF * g.lda * 2, hstepB = (size_t)HALF * g.ldb * 2;
    const size_t tstepA = 2 * hstepA, tstepB = 2 * hstepB;
    const unsigned ldsw = (unsigned)wid * 1024u;
    const int aoff = lds_byte(wr * 64 + fr, fq * 8), boff = lds_byte(wc * 32 + fr, fq * 8);
#define PG8_SA(b, h) (((b) * 2 + (h)) * HTB)
#define PG8_SB(b, h) ((4 + (b) * 2 + (h)) * HTB)
#define PG8_STAGE(bufoff, gbase, voff) do { _Pragma("unroll") for (int _i = 0; _i < 2; ++_i) \
        __builtin_amdgcn_global_load_lds((const unsigned*)((const char*)(gbase) + (voff)[_i]), (LAS unsigned*)(lds + (bufoff) + ldsw + _i * 8192), 16, 0, 0); } while (0)
#define PG8_LDA(dst, b, h) do { _Pragma("unroll") for (int m = 0; m < 4; ++m) _Pragma("unroll") for (int k = 0; k < 2; ++k) dst[m][k] = *(const LAS bf16x8*)(lds + PG8_SA(b, h) + aoff + m * 2048 + k * 1024); } while (0)
#define PG8_LDB(dst, b, h) do { _Pragma("unroll") for (int n = 0; n < 2; ++n) _Pragma("unroll") for (int k = 0; k < 2; ++k) dst[n][k] = *(const LAS bf16x8*)(lds + PG8_SB(b, h) + boff + n * 2048 + k * 1024); } while (0)
#define PG8_MMA(ai, bj, At, Bt) do { __builtin_amdgcn_s_setprio(1); _Pragma("unroll") for (int m = 0; m < 4; ++m) _Pragma("unroll") for (int n = 0; n < 2; ++n) _Pragma("unroll") for (int k = 0; k < 2; ++k) \
        acc[ai][bj][m][n] = __builtin_amdgcn_mfma_f32_16x16x32_bf16(Bt[n][k], At[m][k], acc[ai][bj][m][n], 0, 0, 0); __builtin_amdgcn_s_setprio(0); } while (0)
#define PG8_WAIT_V(n) asm volatile("s_waitcnt vmcnt(" #n ")" ::: "memory")
#define PG8_WAIT_L(n) asm volatile("s_waitcnt lgkmcnt(" #n ")" ::: "memory")
#define PG8_BAR __builtin_amdgcn_s_barrier()
#define PG8_SCHED __builtin_amdgcn_sched_barrier(0)
    Unit cur, nxt; int ui = 0;
    if (!S.next(0, cur)) return;
    f32x4 acc[2][2][4][2];
#pragma unroll
    for (int a = 0; a < 2; ++a)
#pragma unroll
        for (int b = 0; b < 2; ++b)
#pragma unroll
            for (int m = 0; m < 4; ++m)
#pragma unroll
                for (int n = 0; n < 2; ++n) acc[a][b][m][n] = (f32x4){0.f, 0.f, 0.f, 0.f};
    bf16x8 At[4][2], B0[2][2], B1[2][2];
    const char* cA = (const char*)g.A + (size_t)g.mapA.src(cur.pm) * tstepA + (size_t)cur.pn * g.a_pn_step;
    const char* cB = (const char*)g.Bt + (size_t)g.mapB.src(cur.pn) * tstepB;
    PG8_STAGE(PG8_SB(0, 0), cB, voffB); PG8_STAGE(PG8_SA(0, 0), cA, voffA); PG8_STAGE(PG8_SB(0, 1), cB + hstepB, voffB); PG8_STAGE(PG8_SA(0, 1), cA + hstepA, voffA);
    if (wr == 1) PG8_BAR;
    PG8_WAIT_V(4); PG8_BAR;
    PG8_STAGE(PG8_SB(1, 0), cB + kstep, voffB); PG8_STAGE(PG8_SA(1, 0), cA + kstep, voffA); PG8_STAGE(PG8_SB(1, 1), cB + hstepB + kstep, voffB);
    PG8_WAIT_V(6); PG8_BAR;
    for (;;) {
        const bool has_next = S.next(ui + 1, nxt);
        const char* nA = has_next ? (const char*)g.A + (size_t)g.mapA.src(nxt.pm) * tstepA + (size_t)nxt.pn * g.a_pn_step : cA;
        const char* nB = has_next ? (const char*)g.Bt + (size_t)g.mapB.src(nxt.pn) * tstepB : cB;
        for (int t = 0; t < nt; t += 2) {
            const bool last = (t == nt - 2);
            const char* a1 = cA + (size_t)(t + 1) * kstep;
            const char* a2 = last ? nA : cA + (size_t)(t + 2) * kstep; const char* b2 = last ? nB : cB + (size_t)(t + 2) * kstep;
            const char* a3 = a2 + kstep; const char* b3 = b2 + kstep;
            PG8_LDB(B0, 0, 0); PG8_SCHED; PG8_LDA(At, 0, 0); PG8_STAGE(PG8_SA(1, 1), a1 + hstepA, voffA);
            PG8_WAIT_L(8); PG8_BAR; PG8_WAIT_L(0); PG8_MMA(0, 0, At, B0); PG8_BAR; PG8_SCHED;
            PG8_LDB(B1, 0, 1); PG8_STAGE(PG8_SB(0, 0), b2, voffB);
            PG8_BAR; PG8_WAIT_L(0); PG8_MMA(0, 1, At, B1); PG8_BAR;
            PG8_LDA(At, 0, 1); PG8_STAGE(PG8_SA(0, 0), a2, voffA);
            PG8_BAR; PG8_WAIT_L(0); PG8_MMA(1, 0, At, B0); PG8_BAR; PG8_SCHED;
            PG8_STAGE(PG8_SB(0, 1), b2 + hstepB, voffB);
            PG8_WAIT_V(6); PG8_BAR; PG8_MMA(1, 1, At, B1); PG8_BAR;
            PG8_LDB(B0, 1, 0); PG8_SCHED; PG8_LDA(At, 1, 0); PG8_STAGE(PG8_SA(0, 1), a2 + hstepA, voffA);
            PG8_WAIT_L(8); PG8_BAR; PG8_WAIT_L(0); PG8_MMA(0, 0, At, B0); PG8_BAR; PG8_SCHED;
            PG8_LDB(B1, 1, 1); PG8_STAGE(PG8_SB(1, 0), b3, voffB);
            PG8_BAR; PG8_WAIT_L(0); PG8_MMA(0, 1, At, B1); PG8_BAR;
            PG8_LDA(At, 1, 1); PG8_STAGE(PG8_SA(1, 0), a3, voffA);
            PG8_BAR; PG8_WAIT_L(0); PG8_MMA(1, 0, At, B0); PG8_BAR; PG8_SCHED;
            PG8_STAGE(PG8_SB(1, 1), b3 + hstepB, voffB);
            PG8_WAIT_V(6); PG8_BAR; PG8_MMA(1, 1, At, B1); PG8_BAR;
        }
        E(acc, cur, wr, wc, fr, fq);
        if (!has_next) break;
#pragma unroll
        for (int a = 0; a < 2; ++a)
#pragma unroll
            for (int b = 0; b < 2; ++b)
#pragma unroll
                for (int m = 0; m < 4; ++m)
#pragma unroll
                    for (int n = 0; n < 2; ++n) acc[a][b][m][n] = (f32x4){0.f, 0.f, 0.f, 0.f};
        cur = nxt; cA = nA; cB = nB; ++ui;
    }
    PG8_WAIT_V(0);
    if (wr == 0) PG8_BAR;
    PG8_BAR;
#undef PG8_SA
#undef PG8_SB
#undef PG8_STAGE
#undef PG8_LDA
#undef PG8_LDB
#undef PG8_MMA
#undef PG8_WAIT_V
#undef PG8_WAIT_L
#undef PG8_BAR
#undef PG8_SCHED
}
}
using pg8::Unit; using pg8::TileMap; using pg8::Gemm;

typedef f32x4 AccT[2][2][4][2];

struct EpiRes {
    static constexpr bool PERM = false;
    float* X; const float* Xc; const float* Xl; const float* modl; int gi; const float* scale; TileMap mapA;
    __device__ __forceinline__ void operator()(const AccT& acc, const Unit& u, int wr, int wc, int fr, int fq) const {
        asm volatile("" : "+v"(fr), "+v"(fq));
        const int gpm = mapA.src(u.pm);
        const int mb = gpm < 32 ? 32 : (gpm - 32) >> 3;
        const int row0 = gpm * 256 + wr * 64 + fr, col0 = u.pn * 256 + wc * 32 + 4 * fq;
        const float* gp = modl + ((size_t)mb * 6 + gi) * 1024;
        f32x4 gv[2][2];
#pragma unroll
        for (int bj = 0; bj < 2; ++bj)
#pragma unroll
            for (int n = 0; n < 2; ++n) { gv[bj][n] = *(const f32x4*)(gp + col0 + bj * 128 + n * 16); if (scale) gv[bj][n] = gv[bj][n] * *(const f32x4*)(scale + col0 + bj * 128 + n * 16); }
        const float* sbase = (gpm < 32 ? Xc : Xl) + (size_t)row0 * 1024 + col0;
#pragma unroll
        for (int ai = 0; ai < 2; ++ai) {
            f32x4 xo[4][2][2];
#pragma unroll
            for (int m = 0; m < 4; ++m)
#pragma unroll
                for (int bj = 0; bj < 2; ++bj)
#pragma unroll
                    for (int n = 0; n < 2; ++n) xo[m][bj][n] = *(const f32x4*)(sbase + (size_t)(ai * 128 + m * 16) * 1024 + bj * 128 + n * 16);
            __builtin_amdgcn_sched_barrier(0);
#pragma unroll
            for (int m = 0; m < 4; ++m) { float* rowp = X + (size_t)(row0 + ai * 128 + m * 16) * 1024 + col0;
#pragma unroll
                for (int bj = 0; bj < 2; ++bj)
#pragma unroll
                    for (int n = 0; n < 2; ++n) *(f32x4*)(rowp + bj * 128 + n * 16) = xo[m][bj][n] + gv[bj][n] * acc[ai][bj][m][n]; }
            __builtin_amdgcn_sched_barrier(0);
        }
    }
};

struct EpiQK {
    static constexpr bool PERM = true;
    bf16_t* Q; bf16_t* Kk; bf16_t* Vv; const f32x2* cs; TileMap mapA;
    __device__ __forceinline__ void operator()(const AccT& acc, const Unit& u, int wr, int wc, int fr, int fq) const {
        asm volatile("" : "+v"(fr), "+v"(fq));
        const int gpm = mapA.src(u.pm);
        const bool isq = u.pn < 4, isv = u.pn >= 8;
        const bool lat = gpm >= 32 && !isv;
        bf16_t* base = isq ? Q : (isv ? Vv + (size_t)(u.pn - 8) * 256 : Kk);
        const int hh = isv ? 0 : (u.pn & 3);
        const int ldo = isv ? 2048 : 1024;
        const float osc = isq ? 0.0625f : 1.0f;
        const int p0 = 16 * wc + 4 * fq;
        f32x4 ctR[2][2], ctC[4][2];
        if (lat) {
#pragma unroll
            for (int ai = 0; ai < 2; ++ai) { const int pr = ((gpm - 32) * 4 + 2 * ai + wr) & 31;
                ctR[ai][0] = *(const f32x4*)(cs + pr * 64 + p0); ctR[ai][1] = *(const f32x4*)(cs + pr * 64 + p0 + 2); }
#pragma unroll
            for (int m = 0; m < 4; ++m) { const int pc = m * 16 + fr;
                ctC[m][0] = *(const f32x4*)(cs + pc * 64 + p0); ctC[m][1] = *(const f32x4*)(cs + pc * 64 + p0 + 2); }
        }
        __builtin_amdgcn_sched_barrier(0);
#pragma unroll
        for (int ai = 0; ai < 2; ++ai)
#pragma unroll
            for (int m = 0; m < 4; ++m) {
                const int rl = ai * 128 + wr * 64 + m * 16 + fr;
                bf16_t* rowp = base + (size_t)(u.pm * 256 + rl) * ldo + hh * 256 + wc * 32 + 8 * fq;
#pragma unroll
                for (int bj = 0; bj < 2; ++bj) {
                    f32x4 v0 = acc[ai][bj][m][0], v1 = acc[ai][bj][m][1];
                    if (lat) {
                        const f32x4 c01 = bj ? ctC[m][0] : ctR[ai][0], c23 = bj ? ctC[m][1] : ctR[ai][1];
                        f32x4 r0, r1;
                        r0[0] = v0[0] * c01[0] - v0[1] * c01[1]; r0[1] = v0[0] * c01[1] + v0[1] * c01[0];
                        r0[2] = v0[2] * c01[2] - v0[3] * c01[3]; r0[3] = v0[2] * c01[3] + v0[3] * c01[2];
                        r1[0] = v1[0] * c23[0] - v1[1] * c23[1]; r1[1] = v1[0] * c23[1] + v1[1] * c23[0];
                        r1[2] = v1[2] * c23[2] - v1[3] * c23[3]; r1[3] = v1[2] * c23[3] + v1[3] * c23[2];
                        v0 = r0; v1 = r1;
                    }
                    v0 = v0 * osc; v1 = v1 * osc;
                    u32x4 w; w.x = cvt_pk_bf16(v0[0], v0[1]); w.y = cvt_pk_bf16(v0[2], v0[3]); w.z = cvt_pk_bf16(v1[0], v1[1]); w.w = cvt_pk_bf16(v1[2], v1[3]);
                    *(u32x4*)(rowp + bj * 128) = w;
                }
            }
    }
};

struct EpiSiluGN {
    static constexpr bool PERM = true;
    bf16_t* A2; TileMap mapA; const bf16_t* Y; const f32x2* ST; const float* gnw;
    __device__ __forceinline__ void operator()(const AccT& acc, const Unit& u, int wr, int wc, int fr, int fq) const {
        asm volatile("" : "+v"(fr), "+v"(fq));
        const int row0 = mapA.src(u.pm) * 256 + wr * 64 + fr, col0 = u.pn * 256 + wc * 32 + 8 * fq;
        const int hd = u.pn >> 1;
        f32x4 gw[2][2]; f32x2 st[2][4];
#pragma unroll
        for (int bj = 0; bj < 2; ++bj) { gw[bj][0] = *(const f32x4*)(gnw + col0 + bj * 128); gw[bj][1] = *(const f32x4*)(gnw + col0 + bj * 128 + 4); }
#pragma unroll
        for (int ai = 0; ai < 2; ++ai)
#pragma unroll
            for (int m = 0; m < 4; ++m) st[ai][m] = ST[(size_t)(row0 + ai * 128 + m * 16) * 4 + hd];
#pragma unroll
        for (int ai = 0; ai < 2; ++ai) {
            u32x4 yv[4][2];
#pragma unroll
            for (int m = 0; m < 4; ++m)
#pragma unroll
                for (int bj = 0; bj < 2; ++bj) yv[m][bj] = *(const u32x4*)(Y + (size_t)(row0 + ai * 128 + m * 16) * 2048 + col0 + bj * 128);
            __builtin_amdgcn_sched_barrier(0);
#pragma unroll
            for (int m = 0; m < 4; ++m) { bf16_t* rowp = A2 + (size_t)(row0 + ai * 128 + m * 16) * 2048 + col0;
                const float mu = st[ai][m][0], rs = st[ai][m][1];
#pragma unroll
                for (int bj = 0; bj < 2; ++bj) { const f32x4 v0 = acc[ai][bj][m][0], v1 = acc[ai][bj][m][1]; const u32x4 yw = yv[m][bj];
                    const f32x4 y0 = (f32x4){bf_lo(yw.x), bf_hi(yw.x), bf_lo(yw.y), bf_hi(yw.y)}, y1 = (f32x4){bf_lo(yw.z), bf_hi(yw.z), bf_lo(yw.w), bf_hi(yw.w)};
                    const f32x4 n0 = (y0 - mu) * rs * gw[bj][0], n1 = (y1 - mu) * rs * gw[bj][1];
                    const f32x4 s0 = silu4(v0) * n0, s1 = silu4(v1) * n1;
                    u32x4 w; w.x = cvt_pk_bf16(s0[0], s0[1]); w.y = cvt_pk_bf16(s0[2], s0[3]); w.z = cvt_pk_bf16(s1[0], s1[1]); w.w = cvt_pk_bf16(s1[2], s1[3]);
                    *(u32x4*)(rowp + bj * 128) = w; } }
            __builtin_amdgcn_sched_barrier(0);
        }
    }
};

struct EpiSwiglu {
    static constexpr bool PERM = true;
    bf16_t* U; TileMap mapA;
    __device__ __forceinline__ void operator()(const AccT& acc, const Unit& u, int wr, int wc, int fr, int fq) const {
        asm volatile("" : "+v"(fr), "+v"(fq));
        const int gpm = mapA.src(u.pm);
        const int row0 = gpm * 256 + wr * 64 + fr, col0 = u.pn * 128 + wc * 32 + 8 * fq;
#pragma unroll
        for (int ai = 0; ai < 2; ++ai)
#pragma unroll
            for (int m = 0; m < 4; ++m) { bf16_t* rowp = U + (size_t)(row0 + ai * 128 + m * 16) * HID + col0;
                const f32x4 s0 = silu4(acc[ai][0][m][0]) * acc[ai][1][m][0], s1 = silu4(acc[ai][0][m][1]) * acc[ai][1][m][1];
                u32x4 w; w.x = cvt_pk_bf16(s0[0], s0[1]); w.y = cvt_pk_bf16(s0[2], s0[3]); w.z = cvt_pk_bf16(s1[0], s1[1]); w.w = cvt_pk_bf16(s1[2], s1[3]);
                *(u32x4*)rowp = w; }
    }
};

__device__ void norm_phase(const float* Xc, const float* Xl, bf16_t* H, const float* nw, const float* modl, int shi, int sci, int r0, int r1) {
    const int tid_ = opaque_tid(); const int wid = tid_ >> 6, lane = tid_ & 63;
    for (int row = r0 + (blockIdx.x * 8 + wid) * 4; row < r1; row += gridDim.x * 32) {
        const float* xp = (row < TCTX ? Xc : Xl) + (size_t)row * 1024 + lane * 4;
        f32x4 v[4][4]; float ss[4];
#pragma unroll
        for (int u = 0; u < 4; ++u)
#pragma unroll
            for (int q = 0; q < 4; ++q) v[u][q] = *(const f32x4*)(xp + u * 1024 + q * 256);
#pragma unroll
        for (int u = 0; u < 4; ++u) { float a = 0.f;
#pragma unroll
            for (int q = 0; q < 4; ++q) a += v[u][q][0] * v[u][q][0] + v[u][q][1] * v[u][q][1] + v[u][q][2] * v[u][q][2] + v[u][q][3] * v[u][q][3];
            ss[u] = a; }
#pragma unroll
        for (int o = 32; o >= 1; o >>= 1)
#pragma unroll
            for (int u = 0; u < 4; ++u) ss[u] += __int_as_float(__builtin_amdgcn_ds_bpermute((lane ^ o) << 2, __float_as_int(ss[u])));
        const int mb = row < TCTX ? 32 : (row - TCTX) >> 11;
        const float* shp = modl + ((size_t)mb * 6 + shi) * 1024; const float* scp = modl + ((size_t)mb * 6 + sci) * 1024;
#pragma unroll
        for (int q = 0; q < 4; ++q) { const int c = q * 256 + lane * 4;
            const f32x4 w = *(const f32x4*)(nw + c), sh = *(const f32x4*)(shp + c), sc = *(const f32x4*)(scp + c);
            const f32x4 wm = w * (sc + 1.0f);
#pragma unroll
            for (int u = 0; u < 4; ++u) { const float rstd = rsqrtf(ss[u] * (1.0f / 1024.0f) + 1e-6f);
                const f32x4 h = (v[u][q] * rstd) * wm + sh;
                u32x2 o; o.x = cvt_pk_bf16(h[0], h[1]); o.y = cvt_pk_bf16(h[2], h[3]);
                *(u32x2*)(H + (size_t)(row + u) * 1024 + c) = o; } }
    }
}

__device__ void final_norm_phase(const float* X, float* out, const float* nw) {
    const int tid_ = opaque_tid(); const int wid = tid_ >> 6, lane = tid_ & 63;
    for (int row = TCTX + (blockIdx.x * 8 + wid) * 4; row < TT; row += gridDim.x * 32) {
        const float* xp = X + (size_t)row * 1024 + lane * 4;
        f32x4 v[4][4]; float ss[4];
#pragma unroll
        for (int u = 0; u < 4; ++u)
#pragma unroll
            for (int q = 0; q < 4; ++q) v[u][q] = *(const f32x4*)(xp + u * 1024 + q * 256);
#pragma unroll
        for (int u = 0; u < 4; ++u) { float a = 0.f;
#pragma unroll
            for (int q = 0; q < 4; ++q) a += v[u][q][0] * v[u][q][0] + v[u][q][1] * v[u][q][1] + v[u][q][2] * v[u][q][2] + v[u][q][3] * v[u][q][3];
            ss[u] = a; }
#pragma unroll
        for (int o = 32; o >= 1; o >>= 1)
#pragma unroll
            for (int u = 0; u < 4; ++u) ss[u] += __int_as_float(__builtin_amdgcn_ds_bpermute((lane ^ o) << 2, __float_as_int(ss[u])));
#pragma unroll
        for (int q = 0; q < 4; ++q) { const int c = q * 256 + lane * 4; const f32x4 w = *(const f32x4*)(nw + c);
#pragma unroll
            for (int u = 0; u < 4; ++u) { const float rstd = rsqrtf(ss[u] * (1.0f / 1024.0f) + 1e-6f);
                *(f32x4*)(out + (size_t)(row + u - TCTX) * 1024 + c) = (v[u][q] * rstd) * w; } }
    }
}

template <int HW>
__device__ __forceinline__ void pool_item(const bf16_t* H, bf16_t* Dd, int row, int c) {
    int sb, L, t;
    if (row < TCTX) { sb = row & ~255; L = 256; t = row & 255; } else { sb = TCTX + ((row - TCTX) & ~2047); L = 2048; t = (row - TCTX) & 2047; }
    u32x4 wv[2 * HW];
#pragma unroll
    for (int k = 0; k < 2 * HW; ++k) { const int uu = t - HW + k; const bool ok = uu >= 0 && uu < L;
        wv[k] = ok ? *(const u32x4*)(H + (size_t)(sb + uu) * 1024 + c) : (u32x4){0u, 0u, 0u, 0u}; }
    float s[8];
#pragma unroll
    for (int j = 0; j < 8; ++j) s[j] = 0.f;
#pragma unroll
    for (int k = 0; k < 2 * HW; ++k) { const u32x4 w = wv[k];
        s[0] += bf_lo(w.x); s[1] += bf_hi(w.x); s[2] += bf_lo(w.y); s[3] += bf_hi(w.y); s[4] += bf_lo(w.z); s[5] += bf_hi(w.z); s[6] += bf_lo(w.w); s[7] += bf_hi(w.w); }
    const int lo = max(t - HW, 0), hi = min(t + HW, L);
    const float inv = 1.0f / (float)(hi - lo);
    const u32x4 w = wv[HW];
    u32x4 o;
    o.x = cvt_pk_bf16(s[0] * inv - bf_lo(w.x), s[1] * inv - bf_hi(w.x)); o.y = cvt_pk_bf16(s[2] * inv - bf_lo(w.y), s[3] * inv - bf_hi(w.y));
    o.z = cvt_pk_bf16(s[4] * inv - bf_lo(w.z), s[5] * inv - bf_hi(w.z)); o.w = cvt_pk_bf16(s[6] * inv - bf_lo(w.w), s[7] * inv - bf_hi(w.w));
    *(u32x4*)(Dd + (size_t)row * 1024 + c) = o;
}
__device__ void pool_phase(const bf16_t* H, bf16_t* Dd, int r0, int r1) {
    const int tid_ = opaque_tid(); const int wid = tid_ >> 6, lane = tid_ & 63;
    const int nw = (r1 - r0) * 2;
    for (int it = blockIdx.x * 8 + wid; it < nw; it += gridDim.x * 8) {
        const int gi = it & 3, row = r0 + (it >> 2) * 2 + (lane >> 5), c = gi * 256 + (lane & 31) * 8;
        if (gi == 0) pool_item<1>(H, Dd, row, c); else if (gi == 1) pool_item<2>(H, Dd, row, c); else if (gi == 2) pool_item<4>(H, Dd, row, c); else pool_item<8>(H, Dd, row, c);
    }
}

__device__ void stats_phase(const bf16_t* Y, f32x2* ST, int r0) {
    const int tid_ = opaque_tid(); const int wid = tid_ >> 6, lane = tid_ & 63;
    for (int row = r0 + (blockIdx.x * 8 + wid) * 2; row < TT; row += gridDim.x * 16) {
        const size_t off = (size_t)row * 2048 + lane * 8;
        u32x4 yw[8];
#pragma unroll
        for (int hh = 0; hh < 8; ++hh) yw[hh] = *(const u32x4*)(Y + off + hh * 512);
        float y[8][8], sm[8], vq[8];
#pragma unroll
        for (int hh = 0; hh < 8; ++hh) { y[hh][0] = bf_lo(yw[hh].x); y[hh][1] = bf_hi(yw[hh].x); y[hh][2] = bf_lo(yw[hh].y); y[hh][3] = bf_hi(yw[hh].y); y[hh][4] = bf_lo(yw[hh].z); y[hh][5] = bf_hi(yw[hh].z); y[hh][6] = bf_lo(yw[hh].w); y[hh][7] = bf_hi(yw[hh].w);
            float a = 0.f;
#pragma unroll
            for (int j = 0; j < 8; ++j) a += y[hh][j];
            sm[hh] = a; }
#pragma unroll
        for (int o = 32; o >= 1; o >>= 1)
#pragma unroll
            for (int hh = 0; hh < 8; ++hh) sm[hh] += __int_as_float(__builtin_amdgcn_ds_bpermute((lane ^ o) << 2, __float_as_int(sm[hh])));
#pragma unroll
        for (int hh = 0; hh < 8; ++hh) { const float mu = sm[hh] * (1.0f / 512.0f); float a = 0.f; sm[hh] = mu;
#pragma unroll
            for (int j = 0; j < 8; ++j) { const float d = y[hh][j] - mu; a += d * d; }
            vq[hh] = a; }
#pragma unroll
        for (int o = 32; o >= 1; o >>= 1)
#pragma unroll
            for (int hh = 0; hh < 8; ++hh) vq[hh] += __int_as_float(__builtin_amdgcn_ds_bpermute((lane ^ o) << 2, __float_as_int(vq[hh])));
        if (lane < 8) { float mu = sm[0], v = vq[0];
#pragma unroll
            for (int hh = 1; hh < 8; ++hh) { mu = lane == hh ? sm[hh] : mu; v = lane == hh ? vq[hh] : v; }
            ST[(size_t)row * 4 + lane] = (f32x2){mu, rsqrtf(v * (1.0f / 512.0f) + 1e-5f)}; }
    }
}

__device__ __forceinline__ int perm_qk(int c) { const int hh = c >> 8, hf = (c >> 7) & 1, dd = c & 127; return hh * 256 + hf * 128 + (dd & 1) * 64 + (dd >> 1); }

struct ConvD { const float* src; bf16_t* dst; int srcN, K, n0, k0, maptype; };
__device__ __forceinline__ ConvD conv_desc(const Params& p, bf16_t* Wb, int it) {
    int i = it;
    if (i < 1536) { const int j = i / 768, r = i % 768; return ConvD{p.ret_w_in + (size_t)j * 1024 * 6144, Wb + W_RETIN + (size_t)j * 6144 * 1024, 6144, 1024, (r / 8) * 64, (r % 8) * 128, 1}; }
    i -= 1536;
    if (i < 512) { const int j = i / 256, r = i % 256; return ConvD{p.ret_w_out + (size_t)j * 2048 * 1024, Wb + W_RETOUT + (size_t)j * 1024 * 2048, 1024, 2048, (r / 16) * 64, (r % 16) * 128, 0}; }
    i -= 512;
    if (i < 64) { const int jg = i / 8, r = i % 8; return ConvD{p.pool_w + (size_t)jg * 65536, Wb + W_POOL + (size_t)jg * 65536, 256, 256, (r / 2) * 64, (r % 2) * 128, 0}; }
    i -= 64;
    if (i < 2816) { const int l = i / 704, r = i % 704; return ConvD{p.ffn_w_in + (size_t)l * 1024 * 5632, Wb + W_FFNIN + (size_t)l * 5632 * 1024, 5632, 1024, (r / 8) * 64, (r % 8) * 128, 2}; }
    i -= 2816;
    { const int l = i / 352, r = i % 352; return ConvD{p.ffn_w_out + (size_t)l * HID * 1024, Wb + W_FFNOUT + (size_t)l * 1024 * HID, 1024, HID, (r / 22) * 64, (r % 22) * 128, 0}; }
}
__device__ __forceinline__ void conv_load(const ConvD& d, int tid, float (&v)[16]) {
    const int kk = tid >> 6, np = d.n0 + (tid & 63);
    int sc;
    if (d.maptype == 0) sc = np;
    else if (d.maptype == 1) sc = np < 2048 ? 4096 + np : (np < 3072 ? perm_qk(np - 2048) : (np < 4096 ? 1024 + perm_qk(np - 3072) : 2048 + (np - 4096)));
    else sc = ((np >> 7) & 1) * HID + (np >> 8) * 128 + (np & 127);
#pragma unroll
    for (int ps = 0; ps < 16; ++ps) v[ps] = d.src[(size_t)(d.k0 + kk + 8 * ps) * d.srcN + sc];
}
__device__ __forceinline__ void conv_finish(const ConvD& d, int tid, const float (&v)[16], float* lds) {
    { const int kk = tid >> 6, nn = tid & 63;
#pragma unroll
      for (int ps = 0; ps < 16; ++ps) lds[(kk + 8 * ps) * 65 + nn] = v[ps]; }
    __syncthreads();
    { const int nn = tid >> 3, kc = tid & 7;
#pragma unroll
      for (int hh = 0; hh < 2; ++hh) {
        float t[8];
#pragma unroll
        for (int e = 0; e < 8; ++e) t[e] = lds[(64 * hh + 8 * kc + e) * 65 + nn];
        u32x4 w; w.x = cvt_pk_bf16(t[0], t[1]); w.y = cvt_pk_bf16(t[2], t[3]); w.z = cvt_pk_bf16(t[4], t[5]); w.w = cvt_pk_bf16(t[6], t[7]);
        *(u32x4*)(d.dst + (size_t)(d.n0 + nn) * d.K + d.k0 + 64 * hh + 8 * kc) = w; } }
    __syncthreads();
}

__device__ void phase0(const Params& p, float* lds) {
    const int tid = opaque_tid(), wid = tid >> 6, lane = tid & 63;
    float* X = (float*)(p.ws + WS_X);
    bf16_t* Wb = (bf16_t*)((unsigned char*)p.out + OB_W);
    float* MOD = (float*)((unsigned char*)p.out + OB_MOD);
    f32x2* CS = (f32x2*)((unsigned char*)p.out + OB_CS);
    for (int idx = blockIdx.x * 512 + tid; idx < 4096; idx += gridDim.x * 512) {
        const int pos = idx >> 6, pp = idx & 63;
        const float inv = powf(10000.0f, -(float)(2 * pp) / 128.0f);
        const float angf = (float)pos * inv;
        double a = (double)angf;
        const double k = rint(a * 0.6366197723675814);
        const double rr = (a - k * 1.5707963267948966) - k * 6.123233995736766e-17;
        const int qd = ((int)k) & 3;
        const double r2 = rr * rr;
        double sn = rr * (1.0 + r2 * (-1.0 / 6 + r2 * (1.0 / 120 + r2 * (-1.0 / 5040 + r2 * (1.0 / 362880 + r2 * (-1.0 / 39916800 + r2 * (1.0 / 6227020800.0)))))));
        double cn = 1.0 + r2 * (-0.5 + r2 * (1.0 / 24 + r2 * (-1.0 / 720 + r2 * (1.0 / 40320 + r2 * (-1.0 / 3628800 + r2 * (1.0 / 479001600.0 + r2 * (-1.0 / 87178291200.0)))))));
        double cs_, sn_;
        if (qd == 0) { cs_ = cn; sn_ = sn; } else if (qd == 1) { cs_ = -sn; sn_ = cn; } else if (qd == 2) { cs_ = -cn; sn_ = -sn; } else { cs_ = sn; sn_ = -cn; }
        CS[idx] = (f32x2){(float)cs_, (float)sn_};
    }
    for (int it = blockIdx.x; it < 4 * 48; it += gridDim.x) {
        const int layer = it / 48, cb = it % 48;
        for (int idx = tid; idx < 33 * 1024; idx += 512) { const int r = idx >> 10, k = idx & 1023; const float v = r < 32 ? p.c[r * 1024 + k] : p.c_ctx[k]; lds[idx] = silu_f(v); }
        __syncthreads();
        const float* wp = p.ada_w + (size_t)layer * 1024 * 6144 + cb * 128 + 2 * lane;
        f32x2 acc[33];
#pragma unroll
        for (int r = 0; r < 33; ++r) acc[r] = (f32x2){0.f, 0.f};
#pragma unroll 1
        for (int k = wid * 128; k < wid * 128 + 128; k += 4) {
            const f32x2 w0 = *(const f32x2*)(wp + (size_t)k * 6144), w1 = *(const f32x2*)(wp + (size_t)(k + 1) * 6144), w2 = *(const f32x2*)(wp + (size_t)(k + 2) * 6144), w3 = *(const f32x2*)(wp + (size_t)(k + 3) * 6144);
#pragma unroll
            for (int r = 0; r < 33; ++r) { const f32x4 s4 = *(const f32x4*)(lds + r * 1024 + k); acc[r] += w0 * s4[0] + w1 * s4[1] + w2 * s4[2] + w3 * s4[3];
                if ((r & 7) == 7) __builtin_amdgcn_sched_barrier(0); }
        }
        __syncthreads();
#pragma unroll
        for (int r = 0; r < 33; ++r) *(f32x2*)(lds + (wid * 33 + r) * 128 + 2 * lane) = acc[r];
        __syncthreads();
        for (int idx = tid; idx < 33 * 128; idx += 512) { const int r = idx >> 7, l = idx & 127; float sm = 0.f;
#pragma unroll
            for (int w = 0; w < 8; ++w) sm += lds[(w * 33 + r) * 128 + l];
            MOD[((size_t)layer * 33 + r) * 6144 + cb * 128 + l] = sm + p.ada_b[layer * 6144 + cb * 128 + l]; }
        __syncthreads();
    }
    {
        int it = blockIdx.x;
        if (it < 6336) {
            ConvD cur = conv_desc(p, Wb, it);
            float va[16];
            conv_load(cur, tid, va);
            for (;;) {
                const int nx = it + (int)gridDim.x; const bool has = nx < 6336;
                ConvD nd = cur; float vb[16];
#pragma unroll
                for (int q = 0; q < 16; ++q) vb[q] = 0.f;
                if (has) { nd = conv_desc(p, Wb, nx); conv_load(nd, tid, vb); }
                conv_finish(cur, tid, va, lds);
                if (!has) break;
                cur = nd; it = nx;
#pragma unroll
                for (int q = 0; q < 16; ++q) va[q] = vb[q];
            }
        }
    }
}

constexpr int QS_LD = 264, KS_LD = 272, P_LD = 80, QP_LD = 272;
template <int ST>
__device__ __forceinline__ void kt_issue(unsigned addr, u32x2 (&o)[8]) {
    constexpr int RB = KS_LD * 2;
    asm volatile(
        "ds_read_b64_tr_b16 %0, %8 offset:%9\n\t"
        "ds_read_b64_tr_b16 %1, %8 offset:%10\n\t"
        "ds_read_b64_tr_b16 %2, %8 offset:%11\n\t"
        "ds_read_b64_tr_b16 %3, %8 offset:%12\n\t"
        "ds_read_b64_tr_b16 %4, %8 offset:%13\n\t"
        "ds_read_b64_tr_b16 %5, %8 offset:%14\n\t"
        "ds_read_b64_tr_b16 %6, %8 offset:%15\n\t"
        "ds_read_b64_tr_b16 %7, %8 offset:%16"
        : "=&v"(o[0]), "=&v"(o[1]), "=&v"(o[2]), "=&v"(o[3]), "=&v"(o[4]), "=&v"(o[5]), "=&v"(o[6]), "=&v"(o[7])
        : "v"(addr),
          "n"((0 * 32 + 0) * RB + 32 * (2 * ST)), "n"((0 * 32 + 4) * RB + 32 * (2 * ST)),
          "n"((1 * 32 + 0) * RB + 32 * (2 * ST)), "n"((1 * 32 + 4) * RB + 32 * (2 * ST)),
          "n"((0 * 32 + 0) * RB + 32 * (2 * ST + 1)), "n"((0 * 32 + 4) * RB + 32 * (2 * ST + 1)),
          "n"((1 * 32 + 0) * RB + 32 * (2 * ST + 1)), "n"((1 * 32 + 4) * RB + 32 * (2 * ST + 1))
        : "memory");
}
template <int N>
__device__ __forceinline__ void kt_wait(u32x2 (&o)[8]) {
    asm volatile("s_waitcnt lgkmcnt(%8)" : "+v"(o[0]), "+v"(o[1]), "+v"(o[2]), "+v"(o[3]), "+v"(o[4]), "+v"(o[5]), "+v"(o[6]), "+v"(o[7]) : "n"(N) : "memory");
}
constexpr int VS_LD = 136;
__device__ __forceinline__ void vt_issue(unsigned addr, u32x2 (&o)[4]) {
    constexpr int RB = VS_LD * 2;
    asm volatile(
        "ds_read_b64_tr_b16 %0, %4 offset:%5\n\t"
        "ds_read_b64_tr_b16 %1, %4 offset:%6\n\t"
        "ds_read_b64_tr_b16 %2, %4 offset:%7\n\t"
        "ds_read_b64_tr_b16 %3, %4 offset:%8"
        : "=&v"(o[0]), "=&v"(o[1]), "=&v"(o[2]), "=&v"(o[3])
        : "v"(addr), "n"(0 * RB), "n"(4 * RB), "n"(32 * RB), "n"(36 * RB)
        : "memory");
}
__device__ __forceinline__ void vt_wait(u32x2 (&o)[4]) {
    asm volatile("s_waitcnt lgkmcnt(0)" : "+v"(o[0]), "+v"(o[1]), "+v"(o[2]), "+v"(o[3]) : : "memory");
}
__device__ __forceinline__ bf16x8 kt_frag(const u32x2& a, const u32x2& b) { return __builtin_bit_cast(bf16x8, (u32x4){a.x, a.y, b.x, b.y}); }
template <int ST, bool LAST>
__device__ __forceinline__ void kt_step(unsigned addr, u32x2 (&cur)[8], u32x2 (&nxt)[8], f32x4 (&S)[16], const bf16x8 (&Vs)[2], float Gc) {
    if constexpr (!LAST) kt_issue<ST + 1>(addr, nxt);
    kt_wait<LAST ? 0 : 8>(cur);
    constexpr int m0 = 2 * ST, m1 = 2 * ST + 1;
    S[m0] = S[m0] * Gc; S[m1] = S[m1] * Gc;
    S[m0] = __builtin_amdgcn_mfma_f32_16x16x32_bf16(kt_frag(cur[0], cur[1]), Vs[0], S[m0], 0, 0, 0);
    S[m1] = __builtin_amdgcn_mfma_f32_16x16x32_bf16(kt_frag(cur[4], cur[5]), Vs[0], S[m1], 0, 0, 0);
    S[m0] = __builtin_amdgcn_mfma_f32_16x16x32_bf16(kt_frag(cur[2], cur[3]), Vs[1], S[m0], 0, 0, 0);
    S[m1] = __builtin_amdgcn_mfma_f32_16x16x32_bf16(kt_frag(cur[6], cur[7]), Vs[1], S[m1], 0, 0, 0);
}
template <bool WITH_B>
__device__ __forceinline__ void scan_bc(const bf16_t* Ps, const bf16_t* Qp, int r, int g, const bf16x8 (&Vf)[2], const f32x4 (&S)[16], f32x4 (&o1)[4], f32x4 (&o2)[4]) {
    constexpr int S0 = WITH_B ? 0 : 2;
    u32x4 fb[2][4];
    const bf16_t* pp = Ps + r * P_LD + 8 * g;
    const bf16_t* qp = Qp + r * QP_LD + 8 * g;
    if constexpr (WITH_B) {
#pragma unroll
        for (int nt = 0; nt < 4; ++nt) fb[0][nt] = *(const u32x4*)(pp + 16 * nt * P_LD);
    } else {
#pragma unroll
        for (int nt = 0; nt < 4; ++nt) fb[0][nt] = *(const u32x4*)(qp + 16 * nt * QP_LD);
    }
#pragma unroll
    for (int st = S0; st < 10; ++st) {
        const int nx = st + 1;
        if (nx < 2) {
#pragma unroll
            for (int nt = 0; nt < 4; ++nt) fb[nx & 1][nt] = *(const u32x4*)(pp + 16 * nt * P_LD + 32 * nx);
        } else if (nx < 10) {
#pragma unroll
            for (int nt = 0; nt < 4; ++nt) fb[nx & 1][nt] = *(const u32x4*)(qp + 16 * nt * QP_LD + 32 * (nx - 2));
        }
        if (st < 2) {
#pragma unroll
            for (int nt = 0; nt < 4; ++nt) o1[nt] = __builtin_amdgcn_mfma_f32_16x16x32_bf16(Vf[st], __builtin_bit_cast(bf16x8, fb[st & 1][nt]), o1[nt], 0, 0, 0);
        } else {
            const int T = st - 2;
            u32x4 aw; aw.x = cvt_pk_bf16(S[2 * T][0], S[2 * T][1]); aw.y = cvt_pk_bf16(S[2 * T][2], S[2 * T][3]); aw.z = cvt_pk_bf16(S[2 * T + 1][0], S[2 * T + 1][1]); aw.w = cvt_pk_bf16(S[2 * T + 1][2], S[2 * T + 1][3]);
            const bf16x8 a = __builtin_bit_cast(bf16x8, aw);
#pragma unroll
            for (int nt = 0; nt < 4; ++nt) o2[nt] = __builtin_amdgcn_mfma_f32_16x16x32_bf16(a, __builtin_bit_cast(bf16x8, fb[st & 1][nt]), o2[nt], 0, 0, 0);
        }
        __builtin_amdgcn_sched_barrier(0);
    }
}

__device__ void ret_phase(const Params& p, unsigned char* ldsb, int lj, int half) {
    const int tid0 = opaque_tid(), w = __builtin_amdgcn_readfirstlane(tid0 >> 6), lane0 = tid0 & 63, r0_ = lane0 & 15, g0_ = lane0 >> 4;
    bf16_t* Qs = (bf16_t*)ldsb;
    bf16_t* Ks = Qs + 64 * QS_LD;
    bf16_t* Ps = Ks + 64 * KS_LD;
    bf16_t* Vl = Ps + 64 * P_LD;
    bf16_t* Qp = Vl + 64 * VS_LD;
    const bf16_t* Qg = (const bf16_t*)(p.ws + WS_R1);
    const bf16_t* Kg = Qg + (size_t)TH * 1024;
    const bf16_t* Vg = Kg + (size_t)TH * 1024;
    bf16_t* Y = (bf16_t*)(p.ws + WS_Y);
    const int jb = w & 3, ih = w >> 2;
    for (int item = blockIdx.x; item < 256; item += gridDim.x) {
        const int xq = item & 7, yq = item >> 3, sl = yq & 3, bh = (yq >> 2) * 8 + xq, bl = bh >> 2, h = bh & 3;
        const int bglob = half * 16 + bl;
        const float l2gF = -fabsf(p.ret_log_decay[(lj * 2 + 0) * 4 + h]) * 1.4426950408889634f, l2gB = -fabsf(p.ret_log_decay[(lj * 2 + 1) * 4 + h]) * 1.4426950408889634f;
        for (int pass = 0; pass < 2; ++pass) {
            const int dir = 1 - pass;
            const float lg = -fabsf(p.ret_log_decay[(lj * 2 + dir) * 4 + h]);
            const float l2g = lg * 1.4426950408889634f;
            const float Gc = __builtin_amdgcn_exp2f(64.0f * l2g);
            float ge[8];
#pragma unroll
            for (int e = 0; e < 8; ++e) ge[e] = __builtin_amdgcn_exp2f((dir == 0 ? -(float)e : (float)e) * l2g);
            f32x4 S[16];
#pragma unroll
            for (int i = 0; i < 16; ++i) S[i] = (f32x4){0.f, 0.f, 0.f, 0.f};
            u32x4 sq[4], sk[4]; u32x4 sv[2]; u32x2 yold[4];
            auto spos = [&](int c) -> int { return dir == 0 ? 64 * c : (c < 4 ? 192 - 64 * c : 2496 - 64 * c); };
            auto lrow = [&](int s0) -> int { return s0 < 256 ? bl * 256 + s0 : 4096 + bl * 2048 + (s0 - 256); };
            auto grow = [&](int s0) -> int { return s0 < 256 ? bglob * 256 + s0 : TCTX + bglob * 2048 + (s0 - 256); };
            const unsigned vo_qk = (unsigned)(((tid0 >> 5) * 1024 + (tid0 & 31) * 8) * 2);
            const unsigned vo_v = (unsigned)(((tid0 >> 4) * 2048 + (tid0 & 15) * 8) * 2);
            const unsigned vo_y = (unsigned)((r0_ * 2048 + 4 * g0_) * 2);
            auto issueQ = [&](int c) { const char* bq = (const char*)(Qg + (size_t)lrow(spos(c)) * 1024 + h * 256);
#pragma unroll
                for (int k = 0; k < 4; ++k) sq[k] = *(const u32x4*)(bq + (size_t)k * 32768 + vo_qk); };
            auto issueK = [&](int c) { const char* bk = (const char*)(Kg + (size_t)lrow(spos(c)) * 1024 + h * 256);
#pragma unroll
                for (int k = 0; k < 4; ++k) sk[k] = *(const u32x4*)(bk + (size_t)k * 32768 + vo_qk); };
            auto issueVY = [&](int c) { const char* bv = (const char*)(Vg + (size_t)lrow(spos(c)) * 2048 + h * 512 + sl * 128);
#pragma unroll
                for (int k = 0; k < 2; ++k) sv[k] = *(const u32x4*)(bv + (size_t)k * 131072 + vo_v);
                if (pass == 1) { const char* by = (const char*)(Y + (size_t)grow(spos(c)) * 2048 + h * 512 + sl * 128 + 16 * w);
#pragma unroll
                    for (int nt = 0; nt < 4; ++nt) yold[nt] = *(const u32x2*)(by + (size_t)nt * 65536 + vo_y); } };
            issueQ(0); issueK(0); issueVY(0);
            for (int c = 0; c < 36; ++c) {
                const int s0 = spos(c);
                int tid = tid0, r = r0_, g = g0_; asm volatile("" : "+v"(tid), "+v"(r), "+v"(g));
                const int grow0 = grow(s0);
#pragma unroll
                for (int k = 0; k < 4; ++k) { const int ch = tid + 512 * k, ri = ch >> 5, cc = ch & 31;
                    if (pass == 0) *(u32x4*)(Qs + ri * QS_LD + cc * 8) = sq[k];
                    bf16_t* qd_ = Qp + ri * QP_LD + 32 * (cc >> 2) + 16 * (cc & 1) + 4 * ((cc >> 1) & 1);
                    *(u32x2*)qd_ = (u32x2){sq[k].x, sq[k].y}; *(u32x2*)(qd_ + 8) = (u32x2){sq[k].z, sq[k].w};
                    *(u32x4*)(Ks + ri * KS_LD + cc * 8) = sk[k]; }
#pragma unroll
                for (int k = 0; k < 2; ++k) { const int ch = tid + 512 * k, ri = ch >> 4, cc = ch & 15; *(u32x4*)(Vl + ri * VS_LD + cc * 8) = sv[k]; }
                u32x2 yo[4];
#pragma unroll
                for (int nt = 0; nt < 4; ++nt) yo[nt] = yold[nt];
                __syncthreads();
                u32x2 vv[4];
                vt_issue((unsigned)(size_t)Vl + (unsigned)(((8 * g + (r >> 2)) * VS_LD + 16 * w + 4 * (r & 3)) * 2), vv);
                if (c + 1 < 36) issueQ(c + 1);
                vt_wait(vv);
                bf16x8 Vf[2], Vs[2];
#pragma unroll
                for (int t = 0; t < 2; ++t) {
                    const u32x4 vft = (u32x4){vv[2 * t].x, vv[2 * t].y, vv[2 * t + 1].x, vv[2 * t + 1].y};
                    Vf[t] = __builtin_bit_cast(bf16x8, vft);
                    const int j0 = 32 * t + 8 * g;
                    const float base = __builtin_amdgcn_exp2f((dir == 0 ? (float)(63 - j0) : (float)j0) * l2g);
                    const unsigned uu[4] = {vft.x, vft.y, vft.z, vft.w};
                    unsigned oo[4];
#pragma unroll
                    for (int e2 = 0; e2 < 4; ++e2) oo[e2] = cvt_pk_bf16(bf_lo(uu[e2]) * (base * ge[2 * e2]), bf_hi(uu[e2]) * (base * ge[2 * e2 + 1]));
                    Vs[t] = __builtin_bit_cast(bf16x8, (u32x4){oo[0], oo[1], oo[2], oo[3]});
                }
                const bool deadout = (lj == 1) && (s0 < 256);
                if (pass == 0 && !deadout) {
                    f32x4 sc[2] = {(f32x4){0.f, 0.f, 0.f, 0.f}, (f32x4){0.f, 0.f, 0.f, 0.f}};
                    const bf16_t* kp = Ks + (16 * jb + r) * KS_LD + 8 * g;
                    const bf16_t* qp0 = Qs + (32 * ih + r) * QS_LD + 8 * g;
                    bf16x8 ka[2], qb[2][2];
                    ka[0] = *(const bf16x8*)kp; qb[0][0] = *(const bf16x8*)qp0; qb[0][1] = *(const bf16x8*)(qp0 + 16 * QS_LD);
#pragma unroll
                    for (int t = 0; t < 8; ++t) {
                        if (t + 1 < 8) { ka[(t + 1) & 1] = *(const bf16x8*)(kp + 32 * (t + 1)); qb[(t + 1) & 1][0] = *(const bf16x8*)(qp0 + 32 * (t + 1)); qb[(t + 1) & 1][1] = *(const bf16x8*)(qp0 + 16 * QS_LD + 32 * (t + 1)); }
                        sc[0] = __builtin_amdgcn_mfma_f32_16x16x32_bf16(ka[t & 1], qb[t & 1][0], sc[0], 0, 0, 0);
                        sc[1] = __builtin_amdgcn_mfma_f32_16x16x32_bf16(ka[t & 1], qb[t & 1][1], sc[1], 0, 0, 0);
                        __builtin_amdgcn_sched_barrier(0);
                    }
#pragma unroll
                    for (int nt = 0; nt < 2; ++nt) { const int i = 32 * ih + 16 * nt + r; const int j0 = 16 * jb + 4 * g;
                        float pv[4];
#pragma unroll
                        for (int jj = 0; jj < 4; ++jj) { const int df = j0 + jj - i;
                            pv[jj] = sc[nt][jj] * __builtin_amdgcn_exp2f(df > 0 ? (float)df * l2gB : (float)(-df) * l2gF); }
                        u32x2 o; o.x = cvt_pk_bf16(pv[0], pv[1]); o.y = cvt_pk_bf16(pv[2], pv[3]);
                        *(u32x2*)(Ps + i * P_LD + j0) = o; }
                }
                if (c + 1 < 36) issueK(c + 1);
                f32x4 o1[4], o2[4];
#pragma unroll
                for (int nt = 0; nt < 4; ++nt) { o1[nt] = (f32x4){0.f, 0.f, 0.f, 0.f}; o2[nt] = (f32x4){0.f, 0.f, 0.f, 0.f}; }
                if (!deadout) {
                    if (pass == 0) { __syncthreads(); scan_bc<true>(Ps, Qp, r, g, Vf, S, o1, o2); }
                    else if (c > 0) scan_bc<false>(Ps, Qp, r, g, Vf, S, o1, o2);
                }
                if (c + 1 < 36) issueVY(c + 1);
                if (c < 35) {
                    u32x2 fa0[8], fa1[8];
                    const unsigned kaddr = (unsigned)(size_t)Ks + (unsigned)(((8 * g + (r >> 2)) * KS_LD + 4 * (r & 3)) * 2);
                    kt_issue<0>(kaddr, fa0);
                    kt_step<0, false>(kaddr, fa0, fa1, S, Vs, Gc);
                    kt_step<1, false>(kaddr, fa1, fa0, S, Vs, Gc);
                    kt_step<2, false>(kaddr, fa0, fa1, S, Vs, Gc);
                    kt_step<3, false>(kaddr, fa1, fa0, S, Vs, Gc);
                    kt_step<4, false>(kaddr, fa0, fa1, S, Vs, Gc);
                    kt_step<5, false>(kaddr, fa1, fa0, S, Vs, Gc);
                    kt_step<6, false>(kaddr, fa0, fa1, S, Vs, Gc);
                    kt_step<7, true>(kaddr, fa1, fa0, S, Vs, Gc);
                }
                if (!deadout)
#pragma unroll
                for (int nt = 0; nt < 4; ++nt) { const int i = 16 * nt + r;
                    const float qd = __builtin_amdgcn_exp2f((dir == 0 ? (float)(i + 1) : (float)(64 - i)) * l2g);
                    f32x4 yv = o1[nt] + o2[nt] * qd;
                    bf16_t* yp = (bf16_t*)((char*)(Y + (size_t)grow0 * 2048 + h * 512 + sl * 128 + 16 * w) + (size_t)nt * 65536 + vo_y);
                    if (pass == 1) { yv[0] += bf_lo(yo[nt].x); yv[1] += bf_hi(yo[nt].x); yv[2] += bf_lo(yo[nt].y); yv[3] += bf_hi(yo[nt].y); }
                    u32x2 o; o.x = cvt_pk_bf16(yv[0], yv[1]); o.y = cvt_pk_bf16(yv[2], yv[3]);
                    *(u32x2*)yp = o; }
                __syncthreads();
            }
        }
    }
}

__device__ __forceinline__ void gbar(unsigned* ctr, unsigned& target) {
    asm volatile("s_waitcnt vmcnt(0) lgkmcnt(0)" ::: "memory");
    __syncthreads();
    target += gridDim.x;
    if (threadIdx.x == 0) {
        __builtin_amdgcn_fence(__ATOMIC_RELEASE, "agent");
        asm volatile("s_waitcnt vmcnt(0)" ::: "memory");
        __hip_atomic_fetch_add(ctr, 1u, __ATOMIC_RELAXED, __HIP_MEMORY_SCOPE_AGENT);
        while (__hip_atomic_load(ctr, __ATOMIC_RELAXED, __HIP_MEMORY_SCOPE_AGENT) < target) __builtin_amdgcn_s_sleep(2);
        __builtin_amdgcn_fence(__ATOMIC_ACQUIRE, "agent");
        asm volatile("s_waitcnt vmcnt(0)" ::: "memory");
    }
    __syncthreads();
}

__global__ void __launch_bounds__(512, 2) mega(Params p) {
    extern __shared__ __attribute__((aligned(16))) unsigned char shm[];
    cg::grid_group grid = cg::this_grid();
    LAS unsigned char* lds = (LAS unsigned char*)shm;
    float* X = (float*)(p.ws + WS_X);
    unsigned char* R1 = p.ws + WS_R1;
    bf16_t* Y = (bf16_t*)(p.ws + WS_Y);
    bf16_t* H = (bf16_t*)((unsigned char*)p.out + OB_H);
    const bf16_t* Wb = (const bf16_t*)((unsigned char*)p.out + OB_W);
    const float* MOD = (const float*)((unsigned char*)p.out + OB_MOD);
    const f32x2* CS = (const f32x2*)((unsigned char*)p.out + OB_CS);
    const TileMap idm = {1 << 30, 0, 0};
    unsigned* bar = (unsigned*)(p.ws + WS_BAR); unsigned btarget = 0;

    phase0(p, (float*)shm);
    grid.sync();

    for (int layer = 0; layer < 4; ++layer) {
        const bool last = layer == 3;
        const bool use_ret = (layer & 1) == 0;
        const int lj = layer >> 1;
        const float* modl = MOD + (size_t)layer * 33 * 6144;
        const int r0 = last ? TCTX : 0;
        const TileMap rowmap = last ? TileMap{0, 0, 32} : idm;
        const int Mrows = last ? (TT - TCTX) : TT;
        const bool latpost = layer >= 2;
        const int r0p = latpost ? TCTX : 0;
        const TileMap rowmapp = latpost ? TileMap{0, 0, 32} : idm;
        const int Mrowsp = latpost ? (TT - TCTX) : TT;

        const float* Xc = layer == 0 ? p.ctx : X; const float* Xl = layer == 0 ? p.x - (size_t)TCTX * 1024 : X;
        norm_phase(Xc, Xl, H, p.norm1_w + layer * 1024, modl, 0, 1, r0, TT);
        gbar(bar, btarget);

        if (use_ret) {
            const bf16_t* Win = Wb + W_RETIN + (size_t)lj * 6144 * 1024;
            bf16_t* Qg = (bf16_t*)R1; bf16_t* Kg = Qg + (size_t)TH * 1024; bf16_t* VTg = Kg + (size_t)TH * 1024;
            for (int half = 0; half < 2; ++half) {
                const TileMap hm = {16, 16 * half, 32 + 128 * half};
                { Gemm g = {H, Win + (size_t)2048 * 1024, 1024, 1024, TH, 4096, 1024, hm, idm, 0};
                  EpiQK E = {Qg, Kg, VTg, CS, hm};
                  pg8::gemm_phase(lds, g, E); }
                gbar(bar, btarget);
                ret_phase(p, shm, lj, half);
                gbar(bar, btarget);
            }
            stats_phase(Y, (f32x2*)(p.ws + WS_ST), r0p);
            gbar(bar, btarget);
            { Gemm g = {H, Win, 1024, 1024, Mrowsp, 2048, 1024, rowmapp, idm, 0};
              EpiSiluGN E = {(bf16_t*)R1, rowmapp, Y, (const f32x2*)(p.ws + WS_ST), p.ret_gn_w + lj * 2048};
              pg8::gemm_phase(lds, g, E); }
            gbar(bar, btarget);
            { Gemm g = {(const bf16_t*)R1, Wb + W_RETOUT + (size_t)lj * 1024 * 2048, 2048, 2048, Mrowsp, 1024, 2048, rowmapp, idm, 0};
              EpiRes E = {X, Xc, Xl, modl, 2, nullptr, rowmapp};
              pg8::gemm_phase(lds, g, E); }
            gbar(bar, btarget);
        } else {
            pool_phase(H, (bf16_t*)R1, r0, TT);
            gbar(bar, btarget);
            { Gemm g = {(const bf16_t*)R1, Wb + W_POOL + (size_t)lj * 262144, 1024, 256, Mrows, 1024, 256, rowmap, idm, 512};
              EpiRes E = {X, X, X, modl, 2, p.pool_scale + lj * 1024, rowmap};
              pg8::gemm_phase(lds, g, E); }
            gbar(bar, btarget);
        }

        norm_phase(X, X, H, p.norm2_w + layer * 1024, modl, 3, 4, r0p, TT);
        gbar(bar, btarget);
        { Gemm g = {H, Wb + W_FFNIN + (size_t)layer * 5632 * 1024, 1024, 1024, Mrowsp, 5632, 1024, rowmapp, idm, 0};
          EpiSwiglu E = {(bf16_t*)R1, rowmapp};
          pg8::gemm_phase(lds, g, E); }
        gbar(bar, btarget);
        { Gemm g = {(const bf16_t*)R1, Wb + W_FFNOUT + (size_t)layer * 1024 * HID, HID, HID, Mrowsp, 1024, HID, rowmapp, idm, 0};
          EpiRes E = {X, X, X, modl, 5, nullptr, rowmapp};
          pg8::gemm_phase(lds, g, E); }
        gbar(bar, btarget);
    }
    final_norm_phase(X, p.out, p.final_norm_w);
}

extern "C" void kernel_launch(void* const* d_in, const int* in_sizes, int n_in, void* d_out, int out_size, void* d_ws, size_t ws_size, hipStream_t stream) {
    static int grid_blocks = 0;
    if (!grid_blocks) {
        if (ws_size < WS_END || n_in < 17) { fprintf(stderr, "kernel_launch: workspace too small (%zu < %zu) or n_in %d\n", ws_size, (size_t)WS_END, n_in); grid_blocks = -1; return; }
        int dev = 0, cus = 0, per_cu = 0;
        hipGetDevice(&dev);
        hipDeviceGetAttribute(&cus, hipDeviceAttributeMultiprocessorCount, dev);
        if (hipFuncSetAttribute((const void*)mega, hipFuncAttributeMaxDynamicSharedMemorySize, LDS_BYTES) != hipSuccess) { fprintf(stderr, "kernel_launch: hipFuncSetAttribute failed\n"); grid_blocks = -1; return; }
        hipOccupancyMaxActiveBlocksPerMultiprocessor(&per_cu, (const void*)mega, 512, LDS_BYTES);
        if (per_cu < 1) { fprintf(stderr, "kernel_launch: occupancy query returned %d\n", per_cu); per_cu = 1; }
        grid_blocks = cus * per_cu;
    }
    if (grid_blocks < 0) return;
    Params p{};
    p.x = (const float*)d_in[0]; p.c = (const float*)d_in[1]; p.ctx = (const float*)d_in[2]; p.c_ctx = (const float*)d_in[3];
    p.ada_w = (const float*)d_in[4]; p.ada_b = (const float*)d_in[5]; p.norm1_w = (const float*)d_in[6]; p.norm2_w = (const float*)d_in[7];
    p.ret_w_in = (const float*)d_in[8]; p.ret_log_decay = (const float*)d_in[9]; p.ret_gn_w = (const float*)d_in[10]; p.ret_w_out = (const float*)d_in[11];
    p.pool_w = (const float*)d_in[12]; p.pool_scale = (const float*)d_in[13]; p.ffn_w_in = (const float*)d_in[14]; p.ffn_w_out = (const float*)d_in[15];
    p.final_norm_w = (const float*)d_in[16];
    p.out = (float*)d_out; p.ws = (unsigned char*)d_ws;
    if (hipMemsetAsync((unsigned char*)d_ws + WS_BAR, 0, 256, stream) != hipSuccess) { fprintf(stderr, "kernel_launch: memset failed\n"); return; }
    void* args[] = {&p};
    hipError_t e = hipLaunchCooperativeKernel((const void*)mega, dim3(grid_blocks), dim3(512), args, LDS_BYTES, stream);
    if (e != hipSuccess) fprintf(stderr, "cooperative launch failed: %s (grid %d)\n", hipGetErrorString(e), grid_blocks);
}
```
